# Optimizing an MI355X kernel written in HIP

```python
import jax, jax.numpy as jnp
from jax import lax
import numpy as np

D_MODEL = 1024
BATCH = 16
SEQ = 2048
DEPTH = 4

CTX_LEN = 256
GRID_W = 64

ML_W = D_MODEL // 2
ML_HEADS = 4
ML_DH = ML_W // ML_HEADS
ML_CHUNK = 128
CV_W = D_MODEL // 4
CV_GROUPS = 4
CV_WIDTH = 3
GM_W = D_MODEL // 4
GM_GROUPS = 4
GM_CHUNK = 128
N_GATES = 4 * ML_HEADS
D_FF = ((8 * D_MODEL // 3 + 255) // 256) * 256
EPS = 1e-6

OFF_K = 0
OFF_V = OFF_K + ML_W
OFF_G = OFF_V + ML_W
OFF_Q = OFF_G + N_GATES
OFF_O = OFF_Q + ML_W
OFF_CV = OFF_O + ML_W
OFF_GM = OFF_CV + 3 * CV_W
D_IN = OFF_GM + 2 * GM_W

kernel_name = "hybrid_mlstm_conv_gmlp_dit"


def _rmsnorm(x, g):
    xf = x.astype(jnp.float32)
    y = xf * lax.rsqrt(jnp.mean(xf * xf, axis=-1, keepdims=True) + EPS) * g.astype(jnp.float32)
    return y.astype(x.dtype)


def _modulation(c_vec, w_ada, b_ada):
    return jnp.split(jax.nn.silu(c_vec) @ w_ada + b_ada, 6, axis=-1)


def _modulate(h, shift, scale):
    return h * (1 + scale) + shift


def _swiglu(h, w1, w3, w2):
    return (jax.nn.silu(h @ w1) * (h @ w3)) @ w2


def _flip(a):
    return jnp.flip(a, axis=2)


def _heads(a):
    bsz, t, _ = a.shape
    return a.reshape(bsz, t, ML_HEADS, ML_DH).transpose(0, 2, 1, 3).astype(jnp.float32)


def _mlstm_kvg(p, b_gates):
    k = _heads(p[..., OFF_K:OFF_K + ML_W]) * (ML_DH ** -0.5)
    v = _heads(p[..., OFF_V:OFF_V + ML_W])
    bsz, t, _ = p.shape
    g = p[..., OFF_G:OFF_G + N_GATES].astype(jnp.float32) + b_gates.astype(jnp.float32)
    g = g.reshape(bsz, t, 4, ML_HEADS).transpose(2, 0, 3, 1)
    li_f, lf_f = g[0], jax.nn.log_sigmoid(g[1])
    li_b, lf_b = g[2], jax.nn.log_sigmoid(g[3])
    return k, v, (li_f, lf_f, li_b, lf_b)


def _mlstm_qo(p):
    q = _heads(p[..., OFF_Q:OFF_Q + ML_W])
    o = jax.nn.sigmoid(p[..., OFF_O:OFF_O + ML_W].astype(jnp.float32))
    return q, o


def _zero_state(bsz):
    return (jnp.zeros((bsz, ML_HEADS, ML_DH, ML_DH), jnp.float32),
            jnp.zeros((bsz, ML_HEADS, ML_DH), jnp.float32),
            jnp.zeros((bsz, ML_HEADS), jnp.float32))


def _mlstm_chunks(q, k, v, li, lf, state):
    bsz, nh, t, dh = q.shape
    nc = t // ML_CHUNK

    def chunk(a):
        a = a.reshape(bsz, nh, nc, ML_CHUNK, *a.shape[3:])
        return jnp.moveaxis(a, 2, 0)

    lower = jnp.tril(jnp.ones((ML_CHUNK, ML_CHUNK), bool))

    def step(carry, inp):
        c_st, n_st, m_st = carry
        qc, kc, vc, lic, lfc = inp
        b = jnp.cumsum(lfc, axis=-1)
        dmat = b[..., :, None] - b[..., None, :] + lic[..., None, :]
        dmat = jnp.where(lower, dmat, -jnp.inf)
        m_inter = b + m_st[..., None]
        m_t = jnp.maximum(m_inter, jnp.max(dmat, axis=-1))
        s = jnp.einsum('bhtd,bhsd->bhts', qc, kc) * jnp.exp(dmat - m_t[..., None])
        inter = jnp.exp(m_inter - m_t)
        num = (jnp.einsum('bhts,bhsd->bhtd', s, vc)
               + inter[..., None] * jnp.einsum('bhtk,bhkv->bhtv', qc, c_st))
        den = jnp.sum(s, axis=-1) + inter * jnp.einsum('bhtk,bhk->bht', qc, n_st)
        h = num / jnp.maximum(jnp.abs(den), jnp.exp(-m_t))[..., None]
        m_new = m_t[..., -1]
        decay = jnp.exp(m_inter[..., -1] - m_new)
        ws = jnp.exp(b[..., -1:] - b + lic - m_new[..., None])
        c_new = decay[..., None, None] * c_st + jnp.einsum('bhs,bhsk,bhsv->bhkv', ws, kc, vc)
        n_new = decay[..., None] * n_st + jnp.einsum('bhs,bhsk->bhk', ws, kc)
        return (c_new, n_new, m_new), h

    state, h = lax.scan(step, state, (chunk(q), chunk(k), chunk(v), chunk(li), chunk(lf)))
    h = jnp.moveaxis(h, 0, 2).reshape(bsz, nh, t, dh)
    return h, state


def _mlstm_final_state(k, v, li, lf):
    b = jnp.cumsum(lf, axis=-1)
    b_end = b[..., -1:]
    logw = b_end - b + li
    m = jnp.maximum(b_end[..., 0], jnp.max(logw, axis=-1))
    w = jnp.exp(logw - m[..., None])
    c_st = jnp.einsum('bhs,bhsk,bhsv->bhkv', w, k, v)
    n_st = jnp.einsum('bhs,bhsk->bhk', w, k)
    return (c_st, n_st, m)


def _mlstm_out(h, o, ml_norm, dtype):
    hn = h * lax.rsqrt(jnp.mean(h * h, axis=-1, keepdims=True) + EPS) * ml_norm[:, None, :].astype(jnp.float32)
    bsz, _, t, _ = h.shape
    hn = hn.transpose(0, 2, 1, 3).reshape(bsz, t, ML_W)
    return (o * hn).astype(dtype)


def _mlstm_bidir(p, b_gates, ml_norm, st_f, st_b):
    q, o = _mlstm_qo(p)
    k, v, (li_f, lf_f, li_b, lf_b) = _mlstm_kvg(p, b_gates)
    h_f, st_f_out = _mlstm_chunks(q, k, v, li_f, lf_f, st_f)
    h_b, st_b_out = _mlstm_chunks(_flip(q), _flip(k), _flip(v), _flip(li_b), _flip(lf_b), st_b)
    return _mlstm_out(h_f + _flip(h_b), o, ml_norm, p.dtype), st_f_out, st_b_out


def _short_conv(p, w_conv, grid):
    bsz, t, _ = p.shape
    gb = p[..., OFF_CV:OFF_CV + CV_W]
    gc = p[..., OFF_CV + CV_W:OFF_CV + 2 * CV_W]
    hin = p[..., OFF_CV + 2 * CV_W:OFF_CV + 3 * CV_W]
    z = gc * hin
    if grid:
        rows = t // GRID_W
        z = z.reshape(bsz, rows, GRID_W, CV_W)
    zp = jnp.pad(z, [(0, 0)] * (z.ndim - 2) + [(1, 1), (0, 0)])
    y = w_conv[0] * zp[..., :-2, :] + w_conv[1] * zp[..., 1:-1, :] + w_conv[2] * zp[..., 2:, :]
    return gb * y.reshape(bsz, t, CV_W)


def _chunk_mlp(p, gm_norm, w_s, b_s):
    bsz, t, _ = p.shape
    u = p[..., OFF_GM:OFF_GM + GM_W]
    v = _rmsnorm(p[..., OFF_GM + GM_W:OFF_GM + 2 * GM_W], gm_norm)
    v = v.reshape(bsz, t // GM_CHUNK, GM_CHUNK, GM_GROUPS, GM_W // GM_GROUPS)
    z = jnp.einsum('gts,bnsgc->bntgc', w_s, v) + b_s.T[:, :, None]
    return u * z.reshape(bsz, t, GM_W)


def setup_inputs(seed: int = 0) -> dict:
    key = jax.random.key(seed)
    ks = jax.random.split(key, 24)
    f32 = jnp.float32
    nrm = lambda k, shape, s: jax.random.normal(k, shape, f32) * s
    fbias = jnp.linspace(3.0, 6.0, ML_HEADS, dtype=f32)
    zb = jnp.zeros((ML_HEADS,), f32)
    gate_base = jnp.concatenate([zb, fbias, zb, fbias])
    return {
        "x": nrm(ks[0], (BATCH, SEQ, D_MODEL), 1.0),
        "c": nrm(ks[1], (BATCH, D_MODEL), 1.0),
        "ctx": nrm(ks[2], (BATCH, CTX_LEN, D_MODEL), 1.0),
        "c_ctx": nrm(ks[3], (D_MODEL,), 1.0),
        "w_ada": nrm(ks[4], (DEPTH, D_MODEL, 6 * D_MODEL), 0.5 * D_MODEL ** -0.5),
        "b_ada": nrm(ks[5], (DEPTH, 6 * D_MODEL), 0.02),
        "norm1": 1.0 + nrm(ks[6], (DEPTH, D_MODEL), 0.05),
        "norm2": 1.0 + nrm(ks[7], (DEPTH, D_MODEL), 0.05),
        "w_in": nrm(ks[8], (DEPTH, D_MODEL, D_IN), D_MODEL ** -0.5),
        "b_gates": gate_base + nrm(ks[9], (DEPTH, N_GATES), 0.1),
        "ml_norm": 1.0 + nrm(ks[10], (DEPTH, ML_HEADS, ML_DH), 0.05),
        "conv_w": nrm(ks[11], (DEPTH, CV_WIDTH, CV_W), CV_WIDTH ** -0.5),
        "gm_norm": 1.0 + nrm(ks[12], (DEPTH, GM_W), 0.05),
        "gm_ws": nrm(ks[13], (DEPTH, GM_GROUPS, GM_CHUNK, GM_CHUNK), GM_CHUNK ** -0.5),
        "gm_bs": 1.0 + nrm(ks[14], (DEPTH, GM_GROUPS, GM_CHUNK), 0.1),
        "w_out": nrm(ks[15], (DEPTH, D_MODEL, D_MODEL), D_MODEL ** -0.5),
        "w1": nrm(ks[16], (DEPTH, D_MODEL, D_FF), D_MODEL ** -0.5),
        "w3": nrm(ks[17], (DEPTH, D_MODEL, D_FF), D_MODEL ** -0.5),
        "w2": nrm(ks[18], (DEPTH, D_FF, D_MODEL), D_FF ** -0.5),
        "norm_f": 1.0 + nrm(ks[19], (D_MODEL,), 0.05),
    }


def reference(x, c, ctx, c_ctx, w_ada, b_ada, norm1, norm2, w_in, b_gates, ml_norm,
              conv_w, gm_norm, gm_ws, gm_bs, w_out, w1, w3, w2, norm_f):
    bsz = x.shape[0]
    for l in range(DEPTH):
        last = l == DEPTH - 1
        sh1, sc1, g1, sh2, sc2, g2 = [m[:, None, :] for m in _modulation(c, w_ada[l], b_ada[l])]
        csh1, csc1, cg1, csh2, csc2, cg2 = _modulation(c_ctx, w_ada[l], b_ada[l])
        hc = _modulate(_rmsnorm(ctx, norm1[l]), csh1, csc1)
        if last:
            pc = hc @ w_in[l][:, :OFF_Q]
            kc, vc, (lic_f, lfc_f, lic_b, lfc_b) = _mlstm_kvg(pc, b_gates[l])
            st_f = _mlstm_final_state(kc, vc, lic_f, lfc_f)
            st_b = _mlstm_final_state(_flip(kc), _flip(vc), _flip(lic_b), _flip(lfc_b))
        else:
            pc = hc @ w_in[l]
            zero = _zero_state(bsz)
            ml_c, st_f, st_b = _mlstm_bidir(pc, b_gates[l], ml_norm[l], zero, zero)
            mix_c = jnp.concatenate([ml_c,
                                     _short_conv(pc, conv_w[l], False),
                                     _chunk_mlp(pc, gm_norm[l], gm_ws[l], gm_bs[l])], axis=-1)
            ctx = ctx + cg1 * (mix_c @ w_out[l])
            hc2 = _modulate(_rmsnorm(ctx, norm2[l]), csh2, csc2)
            ctx = ctx + cg2 * _swiglu(hc2, w1[l], w3[l], w2[l])
        hx = _modulate(_rmsnorm(x, norm1[l]), sh1, sc1)
        px = hx @ w_in[l]
        ml_x, _, _ = _mlstm_bidir(px, b_gates[l], ml_norm[l], st_f, st_b)
        mix_x = jnp.concatenate([ml_x,
                                 _short_conv(px, conv_w[l], True),
                                 _chunk_mlp(px, gm_norm[l], gm_ws[l], gm_bs[l])], axis=-1)
        x = x + g1 * (mix_x @ w_out[l])
        hx2 = _modulate(_rmsnorm(x, norm2[l]), sh2, sc2)
        x = x + g2 * _swiglu(hx2, w1[l], w3[l], w2[l])
    return _rmsnorm(x, norm_f)
```

```cpp
#include <hip/hip_runtime.h>
#include <hip/hip_cooperative_groups.h>
#include <cstdio>
namespace cg = cooperative_groups;
__device__ __forceinline__ int tid_l() { int t = threadIdx.x; asm volatile("" : "+v"(t)); return t; }
__device__ __forceinline__ int bid_l() { int t = blockIdx.x; asm volatile("" : "+s"(t)); return t; }
namespace pg8 {
#define PG8_LAS __attribute__((address_space(3)))
typedef unsigned short bf16_t;
typedef short bf16x8 __attribute__((ext_vector_type(8)));
typedef float f32x4 __attribute__((ext_vector_type(4)));
typedef unsigned u32x4 __attribute__((ext_vector_type(4)));
constexpr int BM = 256, BK = 64, HALF = 128, HTB = HALF * BK * 2  , STAGE_BYTES = 8 * HTB, NXCD = 8, WGM = 8;

__host__ __device__ __forceinline__ int lds_byte(int r, int c) { const int st = (r >> 4) * 2 + (c >> 5), rr = r & 15, cc = c & 31, ob = rr * 64 + cc * 2; return st * 1024 + (ob ^ (((ob >> 9) & 1) << 5)); }
__host__ __device__ __forceinline__ void stage_rc(int b, int& R, int& C) { const int st = b / 1024, sb = b % 1024, swz = sb ^ (((sb >> 9) & 1) << 5); R = (st >> 1) * 16 + swz / 64; C = (st & 1) * 32 + (swz % 64) / 2; }
__host__ __device__ __forceinline__ int perm32(int rho) { const int n = rho >> 4, i = rho & 15; return 8 * (i >> 2) + 4 * n + (i & 3); }

struct Unit { int pm, pn; };
struct Gemm { const bf16_t* A; const bf16_t* Bt; int M, N, K; };

struct StaticOrder {
    int nM, nN, nwg, G, c;
    __host__ __device__ void init(int M, int N, int G_, int c_) { nM = M / BM; nN = N / BM; nwg = nM * nN; G = G_; c = c_; }
    __host__ __device__ bool next(int i, Unit& u) const {
        const long L = (long)i * G + c; if (L >= nwg) return false;
        int wgid = (int)L; { const int q = nwg / NXCD, r = nwg % NXCD, xcd = wgid % NXCD, off = wgid / NXCD; wgid = (xcd < r ? xcd * (q + 1) : r * (q + 1) + (xcd - r) * q) + off; }
        const int nig = WGM * nN, gid = wgid / nig, fm = gid * WGM, gsz = (nM - fm) < WGM ? (nM - fm) : WGM;
        u.pm = fm + ((wgid % nig) % gsz); u.pn = (wgid % nig) / gsz; return true;
    }
    __device__ __forceinline__ void a_ready(const Unit&) const {}
    __device__ __forceinline__ void done(const Unit&) const {}
};
__device__ __forceinline__ unsigned cvt_pk_bf16(float lo, float hi) { unsigned r; asm volatile("v_cvt_pk_bf16_f32 %0, %1, %2" : "=v"(r) : "v"(lo), "v"(hi)); return r; }
template <class Epi, class Sched, bool STAMP = false>
__device__ __forceinline__ void gemm_phase(PG8_LAS unsigned char* lds, const Gemm g, const Sched& S, const Epi& E, unsigned long long* stamps) {
    const int tid = tid_l(), wid = __builtin_amdgcn_readfirstlane(tid >> 6), lane = tid & 63, wr = wid >> 2, wc = wid & 3, fr = lane & 15, fq = lane >> 4;
    const int K = g.K, nt = K / BK;
    int ts_lo = 0, ts_hi = 0, nts = 0; const unsigned long long rt_entry = STAMP ? (unsigned long long)wall_clock64() : 0ull;
#define PG8_STAMP() do { if (STAMP && wid == 0 && nts < 64) { const unsigned long long _c = (unsigned long long)clock64(); \
        ts_lo = (lane == nts) ? (int)(unsigned)_c : ts_lo; ts_hi = (lane == nts) ? (int)(unsigned)(_c >> 32) : ts_hi; ++nts; } } while (0)
    PG8_STAMP();
    unsigned voffA[2], voffB[2];
#pragma unroll
    for (int i = 0; i < 2; ++i) { int R, C; stage_rc(tid * 16 + i * 8192, R, C); const int Rb = Epi::PERM ? ((R & ~31) + perm32(R & 31)) : R;
        voffA[i] = (unsigned)(R * K + C) * 2u; voffB[i] = (unsigned)(Rb * K + C) * 2u; }
    const size_t kstep = (size_t)(BK * 2);
    const size_t hstep = (size_t)HALF * K * 2;
    const size_t tstep = 2 * hstep;
    const unsigned ldsw = (unsigned)wid * 1024u;
    const int aoff = lds_byte(wr * 64 + fr, fq * 8), boff = lds_byte(wc * 32 + fr, fq * 8);
#define PG8_SA(b, h) (((b) * 2 + (h)) * HTB)
#define PG8_SB(b, h) ((4 + (b) * 2 + (h)) * HTB)
#define PG8_STAGE(bufoff, gbase, voff) do { _Pragma("unroll") for (int _i = 0; _i < 2; ++_i) \
        __builtin_amdgcn_global_load_lds((const unsigned*)((const char*)(gbase) + (voff)[_i]), (PG8_LAS unsigned*)(lds + (bufoff) + ldsw + _i * 8192), 16, 0, 0); } while (0)
#define PG8_LDA(dst, b, h) do { _Pragma("unroll") for (int m = 0; m < 4; ++m) _Pragma("unroll") for (int k = 0; k < 2; ++k) dst[m][k] = *(const PG8_LAS bf16x8*)(lds + PG8_SA(b, h) + aoff + m * 2048 + k * 1024); } while (0)
#define PG8_LDB(dst, b, h) do { _Pragma("unroll") for (int n = 0; n < 2; ++n) _Pragma("unroll") for (int k = 0; k < 2; ++k) dst[n][k] = *(const PG8_LAS bf16x8*)(lds + PG8_SB(b, h) + boff + n * 2048 + k * 1024); } while (0)
#define PG8_MMA(ai, bj, At, Bt) do { __builtin_amdgcn_s_setprio(1); _Pragma("unroll") for (int m = 0; m < 4; ++m) _Pragma("unroll") for (int n = 0; n < 2; ++n) _Pragma("unroll") for (int k = 0; k < 2; ++k) \
        acc[ai][bj][m][n] = __builtin_amdgcn_mfma_f32_16x16x32_bf16(Bt[n][k], At[m][k], acc[ai][bj][m][n], 0, 0, 0); __builtin_amdgcn_s_setprio(0); } while (0)
#define PG8_WAIT_V(n) asm volatile("s_waitcnt vmcnt(" #n ")" ::: "memory")
#define PG8_WAIT_L(n) asm volatile("s_waitcnt lgkmcnt(" #n ")" ::: "memory")
#define PG8_BAR __builtin_amdgcn_s_barrier()
#define PG8_SCHED __builtin_amdgcn_sched_barrier(0)
    Unit cur, nxt; int ui = 0;
    if (!S.next(0, cur)) return;
    f32x4 acc[2][2][4][2];
#pragma unroll
    for (int a = 0; a < 2; ++a)
#pragma unroll
        for (int b = 0; b < 2; ++b)
#pragma unroll
            for (int m = 0; m < 4; ++m)
#pragma unroll
                for (int n = 0; n < 2; ++n) acc[a][b][m][n] = (f32x4){0.f, 0.f, 0.f, 0.f};
    bf16x8 At[4][2], B0[2][2], B1[2][2];
    const char* cA = (const char*)g.A + (size_t)cur.pm * tstep; const char* cB = (const char*)g.Bt + (size_t)cur.pn * tstep;
    S.a_ready(cur);
    PG8_STAGE(PG8_SB(0, 0), cB, voffB); PG8_STAGE(PG8_SA(0, 0), cA, voffA); PG8_STAGE(PG8_SB(0, 1), cB + hstep, voffB); PG8_STAGE(PG8_SA(0, 1), cA + hstep, voffA);
    if (wr == 1) PG8_BAR;
    PG8_WAIT_V(4); PG8_BAR;
    PG8_STAGE(PG8_SB(1, 0), cB + kstep, voffB); PG8_STAGE(PG8_SA(1, 0), cA + kstep, voffA); PG8_STAGE(PG8_SB(1, 1), cB + hstep + kstep, voffB);
    PG8_WAIT_V(6); PG8_BAR;
    PG8_STAMP();
    for (;;) {
        const bool has_next = S.next(ui + 1, nxt);
        const char* nA = has_next ? (const char*)g.A + (size_t)nxt.pm * tstep : cA; const char* nB = has_next ? (const char*)g.Bt + (size_t)nxt.pn * tstep : cB;
        for (int t = 0; t < nt; t += 2) {
            const bool last = (t == nt - 2);
            const char* a1 = cA + (size_t)(t + 1) * kstep;
            const char* a2 = last ? nA : cA + (size_t)(t + 2) * kstep; const char* b2 = last ? nB : cB + (size_t)(t + 2) * kstep;
            const char* a3 = a2 + kstep; const char* b3 = b2 + kstep;
            if (last && has_next) S.a_ready(nxt);
            PG8_LDB(B0, 0, 0); PG8_SCHED; PG8_LDA(At, 0, 0); PG8_STAGE(PG8_SA(1, 1), a1 + hstep, voffA);
            PG8_WAIT_L(8); PG8_BAR; PG8_WAIT_L(0); PG8_MMA(0, 0, At, B0); PG8_BAR; PG8_SCHED;
            PG8_LDB(B1, 0, 1); PG8_STAGE(PG8_SB(0, 0), b2, voffB);
            PG8_BAR; PG8_WAIT_L(0); PG8_MMA(0, 1, At, B1); PG8_BAR;
            PG8_LDA(At, 0, 1); PG8_STAGE(PG8_SA(0, 0), a2, voffA);
            PG8_BAR; PG8_WAIT_L(0); PG8_MMA(1, 0, At, B0); PG8_BAR; PG8_SCHED;
            PG8_STAGE(PG8_SB(0, 1), b2 + hstep, voffB);
            PG8_WAIT_V(6); PG8_BAR; PG8_MMA(1, 1, At, B1); PG8_BAR;
            PG8_LDB(B0, 1, 0); PG8_SCHED; PG8_LDA(At, 1, 0); PG8_STAGE(PG8_SA(0, 1), a2 + hstep, voffA);
            PG8_WAIT_L(8); PG8_BAR; PG8_WAIT_L(0); PG8_MMA(0, 0, At, B0); PG8_BAR; PG8_SCHED;
            PG8_LDB(B1, 1, 1); PG8_STAGE(PG8_SB(1, 0), b3, voffB);
            PG8_BAR; PG8_WAIT_L(0); PG8_MMA(0, 1, At, B1); PG8_BAR;
            PG8_LDA(At, 1, 1); PG8_STAGE(PG8_SA(1, 0), a3, voffA);
            PG8_BAR; PG8_WAIT_L(0); PG8_MMA(1, 0, At, B0); PG8_BAR; PG8_SCHED;
            PG8_STAGE(PG8_SB(1, 1), b3 + hstep, voffB);
            PG8_WAIT_V(6); PG8_BAR; PG8_MMA(1, 1, At, B1); PG8_BAR;
        }
        PG8_STAMP();
        if constexpr (!Epi::AFTER_DRAIN) { E(acc, cur, wr, wc, fr, fq); S.done(cur); }
        PG8_STAMP();
        if (!has_next) break;
#pragma unroll
        for (int a = 0; a < 2; ++a)
#pragma unroll
            for (int b = 0; b < 2; ++b)
#pragma unroll
                for (int m = 0; m < 4; ++m)
#pragma unroll
                    for (int n = 0; n < 2; ++n) acc[a][b][m][n] = (f32x4){0.f, 0.f, 0.f, 0.f};
        cur = nxt; cA = nA; cB = nB; ++ui;
    }
    PG8_WAIT_V(0);
    if (wr == 0) PG8_BAR;
    PG8_BAR;
    if constexpr (Epi::AFTER_DRAIN) { E.fused(acc, cur, wr, wc, fr, fq, lds, wid, lane); S.done(cur); }
    PG8_STAMP();
    if (STAMP && wid == 0) { stamps[lane] = lane < nts ? (((unsigned long long)(unsigned)ts_hi << 32) | (unsigned)ts_lo) : 0ull;
        if (lane == 62) stamps[62] = rt_entry; if (lane == 63) stamps[63] = (unsigned long long)wall_clock64(); }
#undef PG8_STAMP
#undef PG8_SA
#undef PG8_SB
#undef PG8_STAGE
#undef PG8_LDA
#undef PG8_LDB
#undef PG8_MMA
#undef PG8_WAIT_V
#undef PG8_WAIT_L
#undef PG8_BAR
#undef PG8_SCHED
}
}

using pg8::bf16_t; using pg8::bf16x8; using pg8::f32x4; using pg8::u32x4; using pg8::cvt_pk_bf16; using pg8::Unit;
#define LAS __attribute__((address_space(3)))
typedef unsigned u32x2 __attribute__((ext_vector_type(2)));

constexpr int D = 1024, NBATCH = 16, SEQ = 2048, CTXL = 256, DEPTH = 4, DIN = 3344, NP = 3328, DFF = 2816;
constexpr int RLAT = NBATCH * SEQ, RCTX = NBATCH * CTXL, ROWS = RLAT + RCTX;
constexpr int PK = 0, PV = 512, PQ = 1024, PO = 1536, PCB = 2048, PCC = 2304, PCH = 2560, PGU = 2816, PGV = 3072;
constexpr float EPS = 1e-6f;
constexpr int LDS_BYTES = 147456;
constexpr int NPHASE = 2 + 8 * DEPTH;
constexpr size_t WS_CTXW = 0;
constexpr size_t WS_ACT = WS_CTXW + (size_t)RCTX * D * 4;
constexpr size_t WS_PBUF = WS_ACT + (size_t)ROWS * D * 2;
constexpr size_t WS_HB = WS_PBUF + (size_t)ROWS * NP * 2;
constexpr size_t WS_GATES = WS_HB + (size_t)ROWS * 512 * 2;
constexpr size_t WS_MOD = WS_GATES + (size_t)ROWS * 16 * 4;
constexpr size_t WS_WB = WS_MOD + (size_t)DEPTH * 17 * 6144 * 4;
constexpr size_t WL_IN = 0, WL_OUT = (size_t)NP * D, WL_13 = WL_OUT + (size_t)D * D, WL_2 = WL_13 + (size_t)2 * DFF * D, WL_SZ = WL_2 + (size_t)D * DFF;
constexpr size_t WS_END = WS_WB + (size_t)DEPTH * WL_SZ * 2;

struct Params { const float* in[20]; float* out; unsigned char* ws; };

__device__ __forceinline__ float bflo(unsigned u) { return __uint_as_float(u << 16); }
__device__ __forceinline__ float bfhi(unsigned u) { return __uint_as_float(u & 0xffff0000u); }
__device__ __forceinline__ float bf2f(short v) { return __uint_as_float(((unsigned)(unsigned short)v) << 16); }
__device__ __forceinline__ f32x4 mfma16(bf16x8 a, bf16x8 b, f32x4 c) { return __builtin_amdgcn_mfma_f32_16x16x32_bf16(a, b, c, 0, 0, 0); }
__device__ __forceinline__ float silu_f(float a) { return a * __builtin_amdgcn_rcpf(1.f + __expf(-a)); }

struct EpiP {
    static constexpr bool PERM = true, AFTER_DRAIN = false;
    bf16_t* O; int ldc;
    __device__ __forceinline__ void operator()(const f32x4 (&acc)[2][2][4][2], const Unit& u, int wr, int wc, int fr, int fq) const {
        const int row0 = u.pm * 256 + wr * 64 + fr, col0 = u.pn * 256 + wc * 32 + 8 * fq;
#pragma unroll
        for (int ai = 0; ai < 2; ++ai)
#pragma unroll
            for (int m = 0; m < 4; ++m) { bf16_t* rowp = O + (size_t)(row0 + ai * 128 + m * 16) * ldc + col0;
#pragma unroll
                for (int bj = 0; bj < 2; ++bj) { const f32x4 v0 = acc[ai][bj][m][0], v1 = acc[ai][bj][m][1];
                    u32x4 w; w.x = cvt_pk_bf16(v0[0], v0[1]); w.y = cvt_pk_bf16(v0[2], v0[3]); w.z = cvt_pk_bf16(v1[0], v1[1]); w.w = cvt_pk_bf16(v1[2], v1[3]);
                    *(u32x4*)(rowp + bj * 128) = w; } }
    }
};
struct EpiSwiglu {
    static constexpr bool PERM = true, AFTER_DRAIN = false;
    bf16_t* O;
    __device__ __forceinline__ void operator()(const f32x4 (&acc)[2][2][4][2], const Unit& u, int wr, int wc, int fr, int fq) const {
        const int row0 = u.pm * 256 + wr * 64 + fr, col0 = u.pn * 128 + wc * 32 + 8 * fq;
#pragma unroll
        for (int ai = 0; ai < 2; ++ai)
#pragma unroll
            for (int m = 0; m < 4; ++m) { bf16_t* rowp = O + (size_t)(row0 + ai * 128 + m * 16) * DFF + col0;
                const f32x4 a0 = acc[ai][0][m][0], a1 = acc[ai][0][m][1], b0 = acc[ai][1][m][0], b1 = acc[ai][1][m][1];
                u32x4 w;
                w.x = cvt_pk_bf16(silu_f(a0[0]) * b0[0], silu_f(a0[1]) * b0[1]); w.y = cvt_pk_bf16(silu_f(a0[2]) * b0[2], silu_f(a0[3]) * b0[3]);
                w.z = cvt_pk_bf16(silu_f(a1[0]) * b1[0], silu_f(a1[1]) * b1[1]); w.w = cvt_pk_bf16(silu_f(a1[2]) * b1[2], silu_f(a1[3]) * b1[3]);
                *(u32x4*)rowp = w; }
    }
};
struct EpiResid {
    static constexpr bool PERM = false, AFTER_DRAIN = false;
    float* xl; float* xc; const float* modl; int goff;
    __device__ __forceinline__ void operator()(const f32x4 (&acc)[2][2][4][2], const Unit& u, int wr, int wc, int fr, int fq) const {
        const int row0 = u.pm * 256 + wr * 64 + fr, col0 = u.pn * 256 + wc * 32 + 4 * fq;
        float* X = u.pm < 128 ? xl + (size_t)row0 * D : xc + (size_t)(row0 - RLAT) * D;
        const float* gp = modl + (size_t)(u.pm < 128 ? (u.pm >> 3) : 16) * 6144 + goff + col0;
        f32x4 gv[2][2];
#pragma unroll
        for (int bj = 0; bj < 2; ++bj)
#pragma unroll
            for (int n = 0; n < 2; ++n) gv[bj][n] = *(const f32x4*)(gp + bj * 128 + n * 16);
#pragma unroll
        for (int ai = 0; ai < 2; ++ai)
#pragma unroll
            for (int m = 0; m < 4; ++m) { float* rowp = X + (size_t)(ai * 128 + m * 16) * D + col0;
#pragma unroll
                for (int bj = 0; bj < 2; ++bj)
#pragma unroll
                    for (int n = 0; n < 2; ++n) { f32x4 xv = *(f32x4*)(rowp + bj * 128 + n * 16); xv += gv[bj][n] * acc[ai][bj][m][n]; *(f32x4*)(rowp + bj * 128 + n * 16) = xv; } }
    }
};

__device__ void phase_prep(const Params& p, LAS unsigned char* lds) {
    const int tid = tid_l(), w = tid >> 6, lane = tid & 63;
    float* MOD = (float*)(p.ws + WS_MOD);
    {
        LAS float* S = (LAS float*)lds;
        LAS float* R = S + 17 * 1024;
        for (int i = tid; i < 17 * 1024; i += 512) { const int r = i >> 10, k = i & 1023; const float v = r < 16 ? p.in[1][r * 1024 + k] : p.in[3][k]; S[i] = v / (1.f + expf(-v)); }
        __syncthreads();
        for (int item = bid_l(); item < 384; item += gridDim.x) {
            const int l = item / 96, n0 = (item % 96) * 64;
            const float* wa = p.in[4] + (size_t)l * 1024 * 6144 + n0 + lane;
            float acc[17];
#pragma unroll
            for (int r = 0; r < 17; ++r) acc[r] = 0.f;
            for (int k4 = 0; k4 < 32; ++k4) {
                const int k = w * 128 + k4 * 4;
                const float w0 = wa[(size_t)k * 6144], w1 = wa[(size_t)(k + 1) * 6144], w2 = wa[(size_t)(k + 2) * 6144], w3 = wa[(size_t)(k + 3) * 6144];
#pragma unroll
                for (int r = 0; r < 17; ++r) { const f32x4 s = *(const LAS f32x4*)(S + r * 1024 + k); acc[r] += s[0] * w0 + s[1] * w1 + s[2] * w2 + s[3] * w3; }
            }
#pragma unroll
            for (int r = 0; r < 17; ++r) R[(w * 17 + r) * 64 + lane] = acc[r];
            __syncthreads();
            for (int o = tid; o < 17 * 64; o += 512) { const int r = o >> 6, n = o & 63; float s = 0.f;
#pragma unroll
                for (int ww = 0; ww < 8; ++ww) s += R[(ww * 17 + r) * 64 + n];
                MOD[((size_t)l * 17 + r) * 6144 + n0 + n] = s + p.in[5][l * 6144 + n0 + n]; }
            __syncthreads();
        }
    }
    {
        LAS float* T = (LAS float*)lds;
        for (int item = bid_l(); item < DEPTH * 3200; item += gridDim.x) {
            const int l = item / 3200; int j = item % 3200;
            bf16_t* WB = (bf16_t*)(p.ws + WS_WB) + (size_t)l * WL_SZ;
            const float* src; int ld, col0, k0, K; bf16_t* dst; float scale = 1.f;
            if (j < 832) { const int n0 = (j >> 4) * 64; k0 = (j & 15) * 64; src = p.in[8] + (size_t)l * D * DIN; ld = DIN; col0 = n0 < 1024 ? n0 : n0 + 16; K = D; dst = WB + WL_IN + (size_t)n0 * D; if (n0 < 512) scale = 0.08838834764831845f; }
            else if (j < 1088) { j -= 832; const int n0 = (j >> 4) * 64; k0 = (j & 15) * 64; src = p.in[15] + (size_t)l * D * D; ld = D; col0 = n0; K = D; dst = WB + WL_OUT + (size_t)n0 * D; }
            else if (j < 2496) { j -= 1088; const int n0 = (j >> 4) * 64; k0 = (j & 15) * 64; const int pn = n0 >> 8, bj = (n0 >> 7) & 1, r0 = n0 & 127;
                src = (bj ? p.in[17] : p.in[16]) + (size_t)l * D * DFF; ld = DFF; col0 = pn * 128 + r0; K = D; dst = WB + WL_13 + (size_t)n0 * D; }
            else { j -= 2496; const int n0 = (j / 44) * 64; k0 = (j % 44) * 64; src = p.in[18] + (size_t)l * DFF * D; ld = D; col0 = n0; K = DFF; dst = WB + WL_2 + (size_t)n0 * DFF; }
#pragma unroll
            for (int hh = 0; hh < 2; ++hh) { const int k = (tid >> 4) + 32 * hh, n4 = (tid & 15) * 4;
                const f32x4 v = *(const f32x4*)(src + (size_t)(k0 + k) * ld + col0 + n4);
                T[k * 65 + n4] = v[0] * scale; T[k * 65 + n4 + 1] = v[1] * scale; T[k * 65 + n4 + 2] = v[2] * scale; T[k * 65 + n4 + 3] = v[3] * scale; }
            __syncthreads();
            { const int n = tid >> 3, k8 = (tid & 7) * 8; u32x4 o;
                o.x = cvt_pk_bf16(T[(k8 + 0) * 65 + n], T[(k8 + 1) * 65 + n]); o.y = cvt_pk_bf16(T[(k8 + 2) * 65 + n], T[(k8 + 3) * 65 + n]);
                o.z = cvt_pk_bf16(T[(k8 + 4) * 65 + n], T[(k8 + 5) * 65 + n]); o.w = cvt_pk_bf16(T[(k8 + 6) * 65 + n], T[(k8 + 7) * 65 + n]);
                *(u32x4*)(dst + (size_t)n * K + k0 + k8) = o; }
            __syncthreads();
        }
    }
    {
        const f32x4* xs = (const f32x4*)p.in[0]; f32x4* xd = (f32x4*)p.out;
        for (size_t i = (size_t)bid_l() * 512 + tid; i < (size_t)RLAT * D / 4; i += (size_t)gridDim.x * 512) xd[i] = xs[i];
        const f32x4* cs = (const f32x4*)p.in[2]; f32x4* cd = (f32x4*)(p.ws + WS_CTXW);
        for (size_t i = (size_t)bid_l() * 512 + tid; i < (size_t)RCTX * D / 4; i += (size_t)gridDim.x * 512) cd[i] = cs[i];
    }
}

template <int MODE> __device__ void phase_norm(const Params& p, int l, int nrows, LAS unsigned char* lds) {
    const int tid = tid_l(), w = tid >> 6, lane = tid & 63;
    LAS float* Wgt = (LAS float*)lds;
    if (MODE == 0) { const float* wi = p.in[8] + (size_t)l * D * DIN + 1024;
        for (int i = tid; i < 16384; i += 512) { const int k = i >> 4, n = i & 15; Wgt[n * 1024 + k] = wi[(size_t)k * DIN + n]; }
        __syncthreads(); }
    const float* nw = MODE == 0 ? p.in[6] + l * D : (MODE == 1 ? p.in[7] + l * D : p.in[19]);
    const float* MOD = (const float*)(p.ws + WS_MOD) + (size_t)l * 17 * 6144;
    bf16_t* ACT = (bf16_t*)(p.ws + WS_ACT); float* GATES = (float*)(p.ws + WS_GATES); float* CTXW = (float*)(p.ws + WS_CTXW);
    f32x4 nv[4];
#pragma unroll
    for (int j = 0; j < 4; ++j) nv[j] = *(const f32x4*)(nw + j * 256 + lane * 4);
    for (int row = bid_l() * 8 + w; row < nrows; row += gridDim.x * 8) {
        float* xr = row < RLAT ? p.out + (size_t)row * D : CTXW + (size_t)(row - RLAT) * D;
        f32x4 xv[4]; float ss = 0.f;
#pragma unroll
        for (int j = 0; j < 4; ++j) { xv[j] = *(const f32x4*)(xr + j * 256 + lane * 4); ss += xv[j][0] * xv[j][0] + xv[j][1] * xv[j][1] + xv[j][2] * xv[j][2] + xv[j][3] * xv[j][3]; }
#pragma unroll
        for (int o = 32; o >= 1; o >>= 1) ss += __shfl_xor(ss, o);
        const float rstd = rsqrtf(ss * (1.f / 1024.f) + EPS);
        if (MODE == 2) {
#pragma unroll
            for (int j = 0; j < 4; ++j) *(f32x4*)(xr + j * 256 + lane * 4) = xv[j] * rstd * nv[j];
            continue;
        }
        const float* mr = MOD + (size_t)(row < RLAT ? (row >> 11) : 16) * 6144 + (MODE == 0 ? 0 : 3072);
        f32x4 y[4];
#pragma unroll
        for (int j = 0; j < 4; ++j) { const f32x4 sh = *(const f32x4*)(mr + j * 256 + lane * 4), scl = *(const f32x4*)(mr + 1024 + j * 256 + lane * 4);
            y[j] = xv[j] * rstd * nv[j] * (scl + 1.f) + sh;
            u32x2 o; o.x = cvt_pk_bf16(y[j][0], y[j][1]); o.y = cvt_pk_bf16(y[j][2], y[j][3]);
            *(u32x2*)(ACT + (size_t)row * D + j * 256 + lane * 4) = o; }
        if (MODE == 0) {
            float gv[16];
#pragma unroll
            for (int n = 0; n < 16; ++n) { float f = 0.f;
#pragma unroll
                for (int j = 0; j < 4; ++j) { const f32x4 wv = *(const LAS f32x4*)(Wgt + n * 1024 + j * 256 + lane * 4); f += y[j][0] * wv[0] + y[j][1] * wv[1] + y[j][2] * wv[2] + y[j][3] * wv[3]; }
                gv[n] = f; }
            { const bool hi = lane & 32;
#pragma unroll
                for (int i = 0; i < 8; ++i) { const float send = hi ? gv[i] : gv[i + 8], keep = hi ? gv[i + 8] : gv[i]; gv[i] = keep + __shfl_xor(send, 32); } }
            { const bool hi = lane & 16;
#pragma unroll
                for (int i = 0; i < 4; ++i) { const float send = hi ? gv[i] : gv[i + 4], keep = hi ? gv[i + 4] : gv[i]; gv[i] = keep + __shfl_xor(send, 16); } }
            { const bool hi = lane & 8;
#pragma unroll
                for (int i = 0; i < 2; ++i) { const float send = hi ? gv[i] : gv[i + 2], keep = hi ? gv[i + 2] : gv[i]; gv[i] = keep + __shfl_xor(send, 8); } }
            { const bool hi = lane & 4; const float send = hi ? gv[0] : gv[1], keep = hi ? gv[1] : gv[0]; gv[0] = keep + __shfl_xor(send, 4); }
            gv[0] += __shfl_xor(gv[0], 2); gv[0] += __shfl_xor(gv[0], 1);
            const int n = (lane >> 2) & 15;
            if ((lane & 3) == 0) GATES[(size_t)row * 16 + n] = gv[0] + p.in[9][l * 16 + n];
        }
    }
}

__device__ void chain_item(const Params& p, int item, bool last, LAS unsigned char* lds) {
    const int tid = tid_l(), w = tid >> 6, lane = tid & 63, fr = lane & 15, fq = lane >> 4;
    const int vh = item & 1, dir = (item >> 1) & 1, h = (item >> 2) & 3, b = item >> 4;
    constexpr int RS = 136;
    LAS bf16_t* Qs = (LAS bf16_t*)lds;
    LAS bf16_t* Kw = Qs + 128 * RS;
    LAS bf16_t* Kwt = Kw + 128 * RS;
    LAS bf16_t* Vt = Kwt + 128 * RS;
    LAS bf16_t* Ct = Vt + 64 * RS;
    LAS float* sc = (LAS float*)(Ct + 64 * RS);
    LAS float *s_lf = sc, *s_li = sc + 128, *s_ws = sc + 256, *s_g = sc + 384, *s_in = sc + 512, *s_em = sc + 640, *s_nv = sc + 768, *s_misc = sc + 896;
    const bf16_t* PB = (const bf16_t*)(p.ws + WS_PBUF); const float* GATES = (const float*)(p.ws + WS_GATES);
    bf16_t* ACT = (bf16_t*)(p.ws + WS_ACT); bf16_t* HB = (bf16_t*)(p.ws + WS_HB);
    for (int i = tid; i < 64 * RS / 2; i += 512) ((LAS unsigned*)Ct)[i] = 0u;
    if (tid < 128) s_nv[tid] = 0.f;
    f32x4 cacc[4];
#pragma unroll
    for (int x = 0; x < 4; ++x) cacc[x] = (f32x4){0.f, 0.f, 0.f, 0.f};
    float nreg = 0.f, m_st = 0.f;
    u32x4 qreg[4], kreg[4], vreg[2];
#define CHUNK_BASE(s) (dir == 0 ? ((s) < 2 ? RLAT + b * CTXL + 128 * (s) : b * SEQ + 128 * ((s) - 2)) : ((s) < 2 ? RLAT + b * CTXL + 128 * (1 - (s)) : b * SEQ + 128 * (17 - (s))))
#define LOAD_CHUNK(s) do { const int _base = CHUNK_BASE(s); \
        _Pragma("unroll") for (int e = 0; e < 4; ++e) { const int _row = e * 32 + (tid >> 4); const int _tok = _base + (dir ? 127 - _row : _row); \
            const bf16_t* _pr = PB + (size_t)_tok * NP + 128 * h + (tid & 15) * 8; qreg[e] = *(const u32x4*)(_pr + PQ); kreg[e] = *(const u32x4*)(_pr + PK); } \
        _Pragma("unroll") for (int e = 0; e < 2; ++e) { const int _idx = e * 512 + tid; const int _row = _idx >> 3; const int _tok = _base + (dir ? 127 - _row : _row); \
            vreg[e] = *(const u32x4*)(PB + (size_t)_tok * NP + PV + 128 * h + 64 * vh + (_idx & 7) * 8); } } while (0)
    LOAD_CHUNK(0);
    for (int s = 0; s < 18; ++s) {
        const int base = CHUNK_BASE(s);
        if (tid < 128) { const int tok = base + (dir ? 127 - tid : tid); const float* g = GATES + (size_t)tok * 16 + dir * 8 + h;
            const float gi = g[0], gf = g[4]; s_li[tid] = gi; s_lf[tid] = fminf(gf, 0.f) - log1pf(expf(-fabsf(gf))); }
#pragma unroll
        for (int e = 0; e < 4; ++e) { const int row = e * 32 + (tid >> 4), c8 = (tid & 15) * 8; *(LAS u32x4*)(Qs + row * RS + c8) = qreg[e]; }
#pragma unroll
        for (int e = 0; e < 2; ++e) { const int idx = e * 512 + tid, row = idx >> 3, c8 = (idx & 7) * 8;
#pragma unroll
            for (int x = 0; x < 4; ++x) { const unsigned u = vreg[e][x]; Vt[(c8 + 2 * x) * RS + row] = (bf16_t)(u & 0xffffu); Vt[(c8 + 2 * x + 1) * RS + row] = (bf16_t)(u >> 16); } }
        __syncthreads();
        if (w == 0) {
            const float l0 = s_lf[2 * lane], l1 = s_lf[2 * lane + 1], i0 = s_li[2 * lane], i1 = s_li[2 * lane + 1];
            float incl = l0 + l1;
#pragma unroll
            for (int off = 1; off < 64; off <<= 1) { const float tv = __shfl_up(incl, off); if (lane >= off) incl += tv; }
            const float b1 = incl, b0 = incl - l1;
            const float a0 = i0 - b0, a1 = i1 - b1;
            float mx = fmaxf(a0, a1);
#pragma unroll
            for (int off = 1; off < 64; off <<= 1) { const float tv = __shfl_up(mx, off); if (lane >= off) mx = fmaxf(mx, tv); }
            float ex = __shfl_up(mx, 1); if (lane == 0) ex = -INFINITY;
            const float c0 = fmaxf(m_st, fmaxf(ex, a0)), c1 = fmaxf(m_st, mx);
            const float c127 = __shfl(c1, 63), b127 = __shfl(b1, 63);
            s_ws[2 * lane] = expf(a0 - c127); s_ws[2 * lane + 1] = expf(a1 - c127);
            s_g[2 * lane] = expf(c127 - c0); s_g[2 * lane + 1] = expf(c127 - c1);
            s_in[2 * lane] = expf(m_st - c0); s_in[2 * lane + 1] = expf(m_st - c1);
            s_em[2 * lane] = expf(-(b0 + c0)); s_em[2 * lane + 1] = expf(-(b1 + c1));
            if (lane == 0) s_misc[0] = expf(m_st - c127);
            m_st = b127 + c127;
        }
        __syncthreads();
#pragma unroll
        for (int e = 0; e < 4; ++e) { const int row = e * 32 + (tid >> 4), c8 = (tid & 15) * 8; const float wv = s_ws[row]; u32x4 o;
#pragma unroll
            for (int x = 0; x < 4; ++x) { const unsigned u = kreg[e][x]; const unsigned pk = cvt_pk_bf16(bflo(u) * wv, bfhi(u) * wv); o[x] = pk;
                Kwt[(c8 + 2 * x) * RS + row] = (bf16_t)(pk & 0xffffu); Kwt[(c8 + 2 * x + 1) * RS + row] = (bf16_t)(pk >> 16); }
            *(LAS u32x4*)(Kw + row * RS + c8) = o; }
        if (s + 1 < 18) LOAD_CHUNK(s + 1);
        __syncthreads();
        const int t = 16 * w + fr;
        bf16x8 qa[4];
#pragma unroll
        for (int kk = 0; kk < 4; ++kk) qa[kk] = *(const LAS bf16x8*)(Qs + t * RS + 32 * kk + 8 * fq);
        float qn = 0.f;
#pragma unroll
        for (int kk = 0; kk < 4; ++kk) { const f32x4 n0 = *(const LAS f32x4*)(s_nv + 32 * kk + 8 * fq), n1 = *(const LAS f32x4*)(s_nv + 32 * kk + 8 * fq + 4);
            qn += bf2f(qa[kk][0]) * n0[0] + bf2f(qa[kk][1]) * n0[1] + bf2f(qa[kk][2]) * n0[2] + bf2f(qa[kk][3]) * n0[3]
                + bf2f(qa[kk][4]) * n1[0] + bf2f(qa[kk][5]) * n1[1] + bf2f(qa[kk][6]) * n1[2] + bf2f(qa[kk][7]) * n1[3]; }
        qn += __shfl_xor(qn, 16); qn += __shfl_xor(qn, 32);
        float rs = 0.f;
#pragma unroll
        for (int n = 0; n < 8; ++n) { f32x4 sa = (f32x4){0.f, 0.f, 0.f, 0.f};
#pragma unroll
            for (int kk = 0; kk < 4; ++kk) { const bf16x8 kb = *(const LAS bf16x8*)(Kw + (16 * n + fr) * RS + 32 * kk + 8 * fq); sa = mfma16(kb, qa[kk], sa); }
#pragma unroll
            for (int r = 0; r < 4; ++r) { const int s_ = 16 * n + 4 * fq + r; sa[r] = (s_ <= t) ? sa[r] : 0.f; rs += sa[r]; }
            u32x2 pk; pk.x = cvt_pk_bf16(sa[0], sa[1]); pk.y = cvt_pk_bf16(sa[2], sa[3]);
            *(LAS u32x2*)(Qs + t * RS + 16 * n + 4 * fq) = pk; }
        rs += __shfl_xor(rs, 16); rs += __shfl_xor(rs, 32);
        f32x4 u1[4], u2[4];
#pragma unroll
        for (int jt = 0; jt < 4; ++jt) { u2[jt] = (f32x4){0.f, 0.f, 0.f, 0.f};
#pragma unroll
            for (int kk = 0; kk < 4; ++kk) { const bf16x8 cb = *(const LAS bf16x8*)(Ct + (16 * jt + fr) * RS + 32 * kk + 8 * fq); u2[jt] = mfma16(cb, qa[kk], u2[jt]); } }
        __syncthreads();
        { bf16x8 pb[4];
#pragma unroll
            for (int kk = 0; kk < 4; ++kk) pb[kk] = *(const LAS bf16x8*)(Qs + t * RS + 32 * kk + 8 * fq);
#pragma unroll
            for (int jt = 0; jt < 4; ++jt) { u1[jt] = (f32x4){0.f, 0.f, 0.f, 0.f};
#pragma unroll
                for (int kk = 0; kk < 4; ++kk) { const bf16x8 vb = *(const LAS bf16x8*)(Vt + (16 * jt + fr) * RS + 32 * kk + 8 * fq); u1[jt] = mfma16(vb, pb[kk], u1[jt]); } } }
        if (!(last && s < 2)) {
            const float gt = s_g[t], it = s_in[t], em = s_em[t];
            const float den = gt * rs + it * qn; const float inv = 1.f / fmaxf(fabsf(den), em);
            const int tok = base + (dir ? 127 - t : t);
            bf16_t* dst = (dir == 0 ? ACT + (size_t)tok * D : HB + (size_t)tok * 512) + 128 * h + 64 * vh + 4 * fq;
#pragma unroll
            for (int jt = 0; jt < 4; ++jt) { u32x2 o; o.x = cvt_pk_bf16((gt * u1[jt][0] + it * u2[jt][0]) * inv, (gt * u1[jt][1] + it * u2[jt][1]) * inv);
                o.y = cvt_pk_bf16((gt * u1[jt][2] + it * u2[jt][2]) * inv, (gt * u1[jt][3] + it * u2[jt][3]) * inv);
                *(u32x2*)(dst + 16 * jt) = o; }
        }
        const float decay = s_misc[0];
        const int jt = w & 3, it0 = (w >> 2) * 4;
#pragma unroll
        for (int x = 0; x < 4; ++x) cacc[x] *= decay;
#pragma unroll
        for (int kk = 0; kk < 4; ++kk) { const bf16x8 vb = *(const LAS bf16x8*)(Vt + (16 * jt + fr) * RS + 32 * kk + 8 * fq);
#pragma unroll
            for (int x = 0; x < 4; ++x) { const bf16x8 ka = *(const LAS bf16x8*)(Kwt + (16 * (it0 + x) + fr) * RS + 32 * kk + 8 * fq); cacc[x] = mfma16(ka, vb, cacc[x]); } }
        { const int i = tid >> 2, part = tid & 3; float sum = 0.f;
#pragma unroll
            for (int y = 0; y < 4; ++y) { const bf16x8 v = *(const LAS bf16x8*)(Kwt + i * RS + 32 * part + 8 * y);
                sum += bf2f(v[0]) + bf2f(v[1]) + bf2f(v[2]) + bf2f(v[3]) + bf2f(v[4]) + bf2f(v[5]) + bf2f(v[6]) + bf2f(v[7]); }
            sum += __shfl_xor(sum, 1); sum += __shfl_xor(sum, 2); nreg = decay * nreg + sum; }
        __syncthreads();
#pragma unroll
        for (int x = 0; x < 4; ++x) { u32x2 o; o.x = cvt_pk_bf16(cacc[x][0], cacc[x][1]); o.y = cvt_pk_bf16(cacc[x][2], cacc[x][3]);
            *(LAS u32x2*)(Ct + (16 * jt + fr) * RS + 16 * (it0 + x) + 4 * fq) = o; }
        if ((tid & 3) == 0) s_nv[tid >> 2] = nreg;
    }
    __syncthreads();
#undef LOAD_CHUNK
#undef CHUNK_BASE
}

__device__ void gmlp_item(const Params& p, int l, int ch, LAS unsigned char* lds) {
    const int tid = tid_l(), w = tid >> 6, lane = tid & 63, fr = lane & 15, fq = lane >> 4;
    constexpr int RS = 136;
    LAS bf16_t* vnt = (LAS bf16_t*)lds;
    const bf16_t* PB = (const bf16_t*)(p.ws + WS_PBUF); bf16_t* ACT = (bf16_t*)(p.ws + WS_ACT);
    const int row0 = ch * 128;
    { const int c8 = (tid & 31) * 8; const float* gn = p.in[12] + l * 256 + c8;
        const f32x4 g0 = *(const f32x4*)gn, g1 = *(const f32x4*)(gn + 4);
#pragma unroll
        for (int ps = 0; ps < 8; ++ps) { const int s = ps * 16 + (tid >> 5);
            const u32x4 v = *(const u32x4*)(PB + (size_t)(row0 + s) * NP + PGV + c8);
            float f[8]; f[0] = bflo(v.x); f[1] = bfhi(v.x); f[2] = bflo(v.y); f[3] = bfhi(v.y); f[4] = bflo(v.z); f[5] = bfhi(v.z); f[6] = bflo(v.w); f[7] = bfhi(v.w);
            float ss = 0.f;
#pragma unroll
            for (int x = 0; x < 8; ++x) ss += f[x] * f[x];
#pragma unroll
            for (int o = 16; o >= 1; o >>= 1) ss += __shfl_xor(ss, o);
            const float rstd = rsqrtf(ss * (1.f / 256.f) + EPS);
            const unsigned p0 = cvt_pk_bf16(f[0] * rstd * g0[0], f[1] * rstd * g0[1]), p1 = cvt_pk_bf16(f[2] * rstd * g0[2], f[3] * rstd * g0[3]);
            const unsigned p2 = cvt_pk_bf16(f[4] * rstd * g1[0], f[5] * rstd * g1[1]), p3 = cvt_pk_bf16(f[6] * rstd * g1[2], f[7] * rstd * g1[3]);
            vnt[(c8 + 0) * RS + s] = (bf16_t)(p0 & 0xffffu); vnt[(c8 + 1) * RS + s] = (bf16_t)(p0 >> 16); vnt[(c8 + 2) * RS + s] = (bf16_t)(p1 & 0xffffu); vnt[(c8 + 3) * RS + s] = (bf16_t)(p1 >> 16);
            vnt[(c8 + 4) * RS + s] = (bf16_t)(p2 & 0xffffu); vnt[(c8 + 5) * RS + s] = (bf16_t)(p2 >> 16); vnt[(c8 + 6) * RS + s] = (bf16_t)(p3 & 0xffffu); vnt[(c8 + 7) * RS + s] = (bf16_t)(p3 >> 16); } }
    __syncthreads();
    const int t = 16 * w + fr;
    const size_t grow = (size_t)(row0 + t);
#pragma unroll 1
    for (int g = 0; g < 4; ++g) {
        const float* wsr = p.in[13] + (((size_t)l * 4 + g) * 128 + t) * 128;
        bf16x8 wb[4];
#pragma unroll
        for (int kk = 0; kk < 4; ++kk) { const f32x4 a = *(const f32x4*)(wsr + 32 * kk + 8 * fq), c = *(const f32x4*)(wsr + 32 * kk + 8 * fq + 4);
            u32x4 o; o.x = cvt_pk_bf16(a[0], a[1]); o.y = cvt_pk_bf16(a[2], a[3]); o.z = cvt_pk_bf16(c[0], c[1]); o.w = cvt_pk_bf16(c[2], c[3]);
            wb[kk] = __builtin_bit_cast(bf16x8, o); }
        const float bs = p.in[14][((size_t)l * 4 + g) * 128 + t];
#pragma unroll
        for (int cc = 0; cc < 4; ++cc) { const int ct = 4 * g + cc; f32x4 acc = (f32x4){0.f, 0.f, 0.f, 0.f};
#pragma unroll
            for (int kk = 0; kk < 4; ++kk) { const bf16x8 va = *(const LAS bf16x8*)(vnt + (16 * ct + fr) * RS + 32 * kk + 8 * fq); acc = mfma16(va, wb[kk], acc); }
            const int c = 16 * ct + 4 * fq;
            const u32x2 uu = *(const u32x2*)(PB + grow * NP + PGU + c);
            u32x2 o; o.x = cvt_pk_bf16(bflo(uu.x) * (acc[0] + bs), bfhi(uu.x) * (acc[1] + bs)); o.y = cvt_pk_bf16(bflo(uu.y) * (acc[2] + bs), bfhi(uu.y) * (acc[3] + bs));
            *(u32x2*)(ACT + grow * D + 768 + c) = o; }
    }
    __syncthreads();
}

__device__ void conv_all(const Params& p, int l, int nrows) {
    const bf16_t* PB = (const bf16_t*)(p.ws + WS_PBUF); bf16_t* ACT = (bf16_t*)(p.ws + WS_ACT);
    const float* cw = p.in[11] + (size_t)l * 3 * 256;
    for (int idx = bid_l() * 512 + tid_l(); idx < nrows * 32; idx += gridDim.x * 512) {
        const int row = idx >> 5, c8 = (idx & 31) * 8;
        bool hp, hn;
        if (row < RLAT) { const int pos = row & 63; hp = pos > 0; hn = pos < 63; } else { const int pos = (row - RLAT) & 255; hp = pos > 0; hn = pos < 255; }
        const bf16_t* pr = PB + (size_t)row * NP + c8;
        const u32x4 gb = *(const u32x4*)(pr + PCB);
        const u32x4 c1 = *(const u32x4*)(pr + PCC), h1 = *(const u32x4*)(pr + PCH);
        u32x4 c0 = (u32x4){0u, 0u, 0u, 0u}, h0 = c0, c2 = c0, h2 = c0;
        if (hp) { c0 = *(const u32x4*)(pr - NP + PCC); h0 = *(const u32x4*)(pr - NP + PCH); }
        if (hn) { c2 = *(const u32x4*)(pr + NP + PCC); h2 = *(const u32x4*)(pr + NP + PCH); }
        u32x4 o;
#pragma unroll
        for (int x = 0; x < 4; ++x) {
            const int c = c8 + 2 * x;
            const float ylo = cw[c] * (bflo(c0[x]) * bflo(h0[x])) + cw[256 + c] * (bflo(c1[x]) * bflo(h1[x])) + cw[512 + c] * (bflo(c2[x]) * bflo(h2[x]));
            const float yhi = cw[c + 1] * (bfhi(c0[x]) * bfhi(h0[x])) + cw[256 + c + 1] * (bfhi(c1[x]) * bfhi(h1[x])) + cw[512 + c + 1] * (bfhi(c2[x]) * bfhi(h2[x]));
            o[x] = cvt_pk_bf16(bflo(gb[x]) * ylo, bfhi(gb[x]) * yhi);
        }
        *(u32x4*)(ACT + (size_t)row * D + 512 + c8) = o;
    }
}

__device__ void combine_all(const Params& p, int l, int nrows) {
    const bf16_t* PB = (const bf16_t*)(p.ws + WS_PBUF); bf16_t* ACT = (bf16_t*)(p.ws + WS_ACT); const bf16_t* HB = (const bf16_t*)(p.ws + WS_HB);
    const float* mn = p.in[10] + (size_t)l * 512;
    for (int idx = bid_l() * 512 + tid_l(); idx < nrows * 64; idx += gridDim.x * 512) {
        const int row = idx >> 6, c8 = (idx & 63) * 8;
        const u32x4 a = *(const u32x4*)(ACT + (size_t)row * D + c8), bb = *(const u32x4*)(HB + (size_t)row * 512 + c8), og = *(const u32x4*)(PB + (size_t)row * NP + PO + c8);
        float f[8]; float ss = 0.f;
#pragma unroll
        for (int x = 0; x < 4; ++x) { f[2 * x] = bflo(a[x]) + bflo(bb[x]); f[2 * x + 1] = bfhi(a[x]) + bfhi(bb[x]); ss += f[2 * x] * f[2 * x] + f[2 * x + 1] * f[2 * x + 1]; }
#pragma unroll
        for (int o = 8; o >= 1; o >>= 1) ss += __shfl_xor(ss, o);
        const float rstd = rsqrtf(ss * (1.f / 128.f) + EPS);
        u32x4 o;
#pragma unroll
        for (int x = 0; x < 4; ++x) {
            const float o0 = 1.f / (1.f + __expf(-bflo(og[x]))), o1 = 1.f / (1.f + __expf(-bfhi(og[x])));
            o[x] = cvt_pk_bf16(o0 * f[2 * x] * rstd * mn[c8 + 2 * x], o1 * f[2 * x + 1] * rstd * mn[c8 + 2 * x + 1]);
        }
        *(u32x4*)(ACT + (size_t)row * D + c8) = o;
    }
}

__device__ __forceinline__ void run_phase(const Params& p, int ph, LAS unsigned char* lds) {
    if (ph == 0) { phase_prep(p, lds); return; }
    if (ph == NPHASE - 1) { phase_norm<2>(p, 0, RLAT, lds); return; }
    const int l = (ph - 1) >> 3, sub = (ph - 1) & 7; const bool last = (l == DEPTH - 1);
    const int nrows = last ? RLAT : ROWS;
    bf16_t* ACT = (bf16_t*)(p.ws + WS_ACT); bf16_t* PBUF = (bf16_t*)(p.ws + WS_PBUF);
    const bf16_t* WB = (const bf16_t*)(p.ws + WS_WB) + (size_t)l * WL_SZ;
    pg8::StaticOrder S;
    if (sub == 0) { phase_norm<0>(p, l, ROWS, lds); }
    else if (sub == 1) { pg8::Gemm g; g.A = ACT; g.Bt = WB + WL_IN; g.M = ROWS; g.N = NP; g.K = D; S.init(g.M, g.N, (int)gridDim.x, (int)bid_l());
        EpiP E; E.O = PBUF; E.ldc = NP; pg8::gemm_phase<EpiP, pg8::StaticOrder, false>(lds, g, S, E, nullptr); }
    else if (sub == 2) {
        for (int item = bid_l(); item < 256; item += gridDim.x) chain_item(p, item, last, lds);
        for (int ch = bid_l(); ch < nrows / 128; ch += gridDim.x) gmlp_item(p, l, ch, lds);
        conv_all(p, l, nrows);
    }
    else if (sub == 3) { combine_all(p, l, nrows); }
    else if (sub == 4 || sub == 7) { pg8::Gemm g; g.M = nrows; g.N = D;
        if (sub == 4) { g.A = ACT; g.Bt = WB + WL_OUT; g.K = D; } else { g.A = PBUF; g.Bt = WB + WL_2; g.K = DFF; }
        S.init(g.M, g.N, (int)gridDim.x, (int)bid_l());
        EpiResid E; E.xl = p.out; E.xc = (float*)(p.ws + WS_CTXW); E.modl = (const float*)(p.ws + WS_MOD) + (size_t)l * 17 * 6144; E.goff = sub == 4 ? 2048 : 5120;
        pg8::gemm_phase<EpiResid, pg8::StaticOrder, false>(lds, g, S, E, nullptr); }
    else if (sub == 5) { phase_norm<1>(p, l, nrows, lds); }
    else { pg8::Gemm g; g.A = ACT; g.Bt = WB + WL_13; g.M = nrows; g.N = 2 * DFF; g.K = D; S.init(g.M, g.N, (int)gridDim.x, (int)bid_l());
        EpiSwiglu E; E.O = PBUF; pg8::gemm_phase<EpiSwiglu, pg8::StaticOrder, false>(lds, g, S, E, nullptr); }
}

__global__ void __launch_bounds__(512, 2) fwd_kernel(Params p, int ph_lo, int ph_hi) {
    extern __shared__ __attribute__((aligned(16))) unsigned char shm[];
    LAS unsigned char* lds = (LAS unsigned char*)shm;
    cg::grid_group grid = cg::this_grid();
    for (int ph = ph_lo; ph < ph_hi; ++ph) {
        run_phase(p, ph, lds);
        if (ph + 1 < ph_hi) grid.sync();
    }
}

extern "C" void kernel_launch(void* const* d_in, const int* in_sizes, int n_in, void* d_out, int out_size, void* d_ws, size_t ws_size, hipStream_t stream) {
    static int grid = 0;
    if (grid == 0) {
        if (n_in != 20 || out_size != RLAT * D || ws_size < WS_END) { fprintf(stderr, "kernel_launch: unexpected shapes (n_in %d, out %d, ws %zu, need %zu)\n", n_in, out_size, ws_size, (size_t)WS_END); grid = -1; return; }
        int dev = 0, cus = 0, per_cu = 0;
        (void)hipGetDevice(&dev); (void)hipDeviceGetAttribute(&cus, hipDeviceAttributeMultiprocessorCount, dev);
        if (hipFuncSetAttribute((const void*)fwd_kernel, hipFuncAttributeMaxDynamicSharedMemorySize, LDS_BYTES) != hipSuccess) { fprintf(stderr, "kernel_launch: hipFuncSetAttribute failed\n"); grid = -1; return; }
        if (hipOccupancyMaxActiveBlocksPerMultiprocessor(&per_cu, (const void*)fwd_kernel, 512, LDS_BYTES) != hipSuccess || per_cu < 1) { fprintf(stderr, "kernel_launch: occupancy query failed (%d)\n", per_cu); (void)hipGetLastError(); per_cu = 1; }
        grid = cus * per_cu;
    }
    if (grid < 0) return;
    Params p{};
    for (int i = 0; i < 20; ++i) p.in[i] = (const float*)d_in[i];
    p.out = (float*)d_out; p.ws = (unsigned char*)d_ws;
    int lo = 0, hi = NPHASE;
    void* args[] = {&p, &lo, &hi};
    hipError_t e = hipLaunchCooperativeKernel((const void*)fwd_kernel, dim3(grid), dim3(512), args, LDS_BYTES, stream);
    if (e != hipSuccess) fprintf(stderr, "kernel_launch: cooperative launch failed: %s (grid %d)\n", hipGetErrorString(e), grid);
}
```

```cpp
#include <hip/hip_runtime.h>
#include <hip/hip_cooperative_groups.h>
#include <cstdio>
namespace cg = cooperative_groups;
__device__ __forceinline__ int tid_l() { int t = threadIdx.x; asm volatile("" : "+v"(t)); return t; }
__device__ __forceinline__ int bid_l() { int t = blockIdx.x; asm volatile("" : "+s"(t)); return t; }
namespace pg8 {
#define PG8_LAS __attribute__((address_space(3)))
typedef unsigned short bf16_t;
typedef short bf16x8 __attribute__((ext_vector_type(8)));
typedef float f32x4 __attribute__((ext_vector_type(4)));
typedef unsigned u32x4 __attribute__((ext_vector_type(4)));
constexpr int BM = 256, BK = 64, HALF = 128, HTB = HALF * BK * 2  , STAGE_BYTES = 8 * HTB, NXCD = 8, WGM = 8;

__host__ __device__ __forceinline__ int lds_byte(int r, int c) { const int st = (r >> 4) * 2 + (c >> 5), rr = r & 15, cc = c & 31, ob = rr * 64 + cc * 2; return st * 1024 + (ob ^ (((ob >> 9) & 1) << 5)); }
__host__ __device__ __forceinline__ void stage_rc(int b, int& R, int& C) { const int st = b / 1024, sb = b % 1024, swz = sb ^ (((sb >> 9) & 1) << 5); R = (st >> 1) * 16 + swz / 64; C = (st & 1) * 32 + (swz % 64) / 2; }
__host__ __device__ __forceinline__ int perm32(int rho) { const int n = rho >> 4, i = rho & 15; return 8 * (i >> 2) + 4 * n + (i & 3); }

struct Unit { int pm, pn; };
struct Gemm { const bf16_t* A; const bf16_t* Bt; int M, N, K; };

struct StaticOrder {
    int nM, nN, nwg, G, c;
    __host__ __device__ void init(int M, int N, int G_, int c_) { nM = M / BM; nN = N / BM; nwg = nM * nN; G = G_; c = c_; }
    __host__ __device__ bool next(int i, Unit& u) const {
        const long L = (long)i * G + c; if (L >= nwg) return false;
        int wgid = (int)L; { const int q = nwg / NXCD, r = nwg % NXCD, xcd = wgid % NXCD, off = wgid / NXCD; wgid = (xcd < r ? xcd * (q + 1) : r * (q + 1) + (xcd - r) * q) + off; }
        const int nig = WGM * nN, gid = wgid / nig, fm = gid * WGM, gsz = (nM - fm) < WGM ? (nM - fm) : WGM;
        u.pm = fm + ((wgid % nig) % gsz); u.pn = (wgid % nig) / gsz; return true;
    }
    __device__ __forceinline__ void a_ready(const Unit&) const {}
    __device__ __forceinline__ void done(const Unit&) const {}
};
__device__ __forceinline__ unsigned cvt_pk_bf16(float lo, float hi) { unsigned r; asm volatile("v_cvt_pk_bf16_f32 %0, %1, %2" : "=v"(r) : "v"(lo), "v"(hi)); return r; }
template <class Epi, class Sched, bool STAMP = false>
__device__ __forceinline__ void gemm_phase(PG8_LAS unsigned char* lds, const Gemm g, const Sched& S, const Epi& E, unsigned long long* stamps) {
    const int tid = tid_l(), wid = __builtin_amdgcn_readfirstlane(tid >> 6), lane = tid & 63, wr = wid >> 2, wc = wid & 3, fr = lane & 15, fq = lane >> 4;
    const int K = g.K, nt = K / BK;
    int ts_lo = 0, ts_hi = 0, nts = 0; const unsigned long long rt_entry = STAMP ? (unsigned long long)wall_clock64() : 0ull;
#define PG8_STAMP() do { if (STAMP && wid == 0 && nts < 64) { const unsigned long long _c = (unsigned long long)clock64(); \
        ts_lo = (lane == nts) ? (int)(unsigned)_c : ts_lo; ts_hi = (lane == nts) ? (int)(unsigned)(_c >> 32) : ts_hi; ++nts; } } while (0)
    PG8_STAMP();
    unsigned voffA[2], voffB[2];
#pragma unroll
    for (int i = 0; i < 2; ++i) { int R, C; stage_rc(tid * 16 + i * 8192, R, C); const int Rb = Epi::PERM ? ((R & ~31) + perm32(R & 31)) : R;
        voffA[i] = (unsigned)(R * K + C) * 2u; voffB[i] = (unsigned)(Rb * K + C) * 2u; }
    const size_t kstep = (size_t)(BK * 2);
    const size_t hstep = (size_t)HALF * K * 2;
    const size_t tstep = 2 * hstep;
    const unsigned ldsw = (unsigned)wid * 1024u;
    const int aoff = lds_byte(wr * 64 + fr, fq * 8), boff = lds_byte(wc * 32 + fr, fq * 8);
#define PG8_SA(b, h) (((b) * 2 + (h)) * HTB)
#define PG8_SB(b, h) ((4 + (b) * 2 + (h)) * HTB)
#define PG8_STAGE(bufoff, gbase, voff) do { _Pragma("unroll") for (int _i = 0; _i < 2; ++_i) \
        __builtin_amdgcn_global_load_lds((const unsigned*)((const char*)(gbase) + (voff)[_i]), (PG8_LAS unsigned*)(lds + (bufoff) + ldsw + _i * 8192), 16, 0, 0); } while (0)
#define PG8_LDA(dst, b, h) do { _Pragma("unroll") for (int m = 0; m < 4; ++m) _Pragma("unroll") for (int k = 0; k < 2; ++k) dst[m][k] = *(const PG8_LAS bf16x8*)(lds + PG8_SA(b, h) + aoff + m * 2048 + k * 1024); } while (0)
#define PG8_LDB(dst, b, h) do { _Pragma("unroll") for (int n = 0; n < 2; ++n) _Pragma("unroll") for (int k = 0; k < 2; ++k) dst[n][k] = *(const PG8_LAS bf16x8*)(lds + PG8_SB(b, h) + boff + n * 2048 + k * 1024); } while (0)
#define PG8_MMA(ai, bj, At, Bt) do { __builtin_amdgcn_s_setprio(1); _Pragma("unroll") for (int m = 0; m < 4; ++m) _Pragma("unroll") for (int n = 0; n < 2; ++n) _Pragma("unroll") for (int k = 0; k < 2; ++k) \
        acc[ai][bj][m][n] = __builtin_amdgcn_mfma_f32_16x16x32_bf16(Bt[n][k], At[m][k], acc[ai][bj][m][n], 0, 0, 0); __builtin_amdgcn_s_setprio(0); } while (0)
#define PG8_WAIT_V(n) asm volatile("s_waitcnt vmcnt(" #n ")" ::: "memory")
#define PG8_WAIT_L(n) asm volatile("s_waitcnt lgkmcnt(" #n ")" ::: "memory")
#define PG8_BAR __builtin_amdgcn_s_barrier()
#define PG8_SCHED __builtin_amdgcn_sched_barrier(0)
    Unit cur, nxt; int ui = 0;
    if (!S.next(0, cur)) return;
    f32x4 acc[2][2][4][2];
#pragma unroll
    for (int a = 0; a < 2; ++a)
#pragma unroll
        for (int b = 0; b < 2; ++b)
#pragma unroll
            for (int m = 0; m < 4; ++m)
#pragma unroll
                for (int n = 0; n < 2; ++n) acc[a][b][m][n] = (f32x4){0.f, 0.f, 0.f, 0.f};
    bf16x8 At[4][2], B0[2][2], B1[2][2];
    const char* cA = (const char*)g.A + (size_t)cur.pm * tstep; const char* cB = (const char*)g.Bt + (size_t)cur.pn * tstep;
    S.a_ready(cur);
    PG8_STAGE(PG8_SB(0, 0), cB, voffB); PG8_STAGE(PG8_SA(0, 0), cA, voffA); PG8_STAGE(PG8_SB(0, 1), cB + hstep, voffB); PG8_STAGE(PG8_SA(0, 1), cA + hstep, voffA);
    if (wr == 1) PG8_BAR;
    PG8_WAIT_V(4); PG8_BAR;
    PG8_STAGE(PG8_SB(1, 0), cB + kstep, voffB); PG8_STAGE(PG8_SA(1, 0), cA + kstep, voffA); PG8_STAGE(PG8_SB(1, 1), cB + hstep + kstep, voffB);
    PG8_WAIT_V(6); PG8_BAR;
    PG8_STAMP();
    for (;;) {
        const bool has_next = S.next(ui + 1, nxt);
        const char* nA = has_next ? (const char*)g.A + (size_t)nxt.pm * tstep : cA; const char* nB = has_next ? (const char*)g.Bt + (size_t)nxt.pn * tstep : cB;
        for (int t = 0; t < nt; t += 2) {
            const bool last = (t == nt - 2);
            const char* a1 = cA + (size_t)(t + 1) * kstep;
            const char* a2 = last ? nA : cA + (size_t)(t + 2) * kstep; const char* b2 = last ? nB : cB + (size_t)(t + 2) * kstep;
            const char* a3 = a2 + kstep; const char* b3 = b2 + kstep;
            if (last && has_next) S.a_ready(nxt);
            PG8_LDB(B0, 0, 0); PG8_SCHED; PG8_LDA(At, 0, 0); PG8_STAGE(PG8_SA(1, 1), a1 + hstep, voffA);
            PG8_WAIT_L(8); PG8_BAR; PG8_WAIT_L(0); PG8_MMA(0, 0, At, B0); PG8_BAR; PG8_SCHED;
            PG8_LDB(B1, 0, 1); PG8_STAGE(PG8_SB(0, 0), b2, voffB);
            PG8_BAR; PG8_WAIT_L(0); PG8_MMA(0, 1, At, B1); PG8_BAR;
            PG8_LDA(At, 0, 1); PG8_STAGE(PG8_SA(0, 0), a2, voffA);
            PG8_BAR; PG8_WAIT_L(0); PG8_MMA(1, 0, At, B0); PG8_BAR; PG8_SCHED;
            PG8_STAGE(PG8_SB(0, 1), b2 + hstep, voffB);
            PG8_WAIT_V(6); PG8_BAR; PG8_MMA(1, 1, At, B1); PG8_BAR;
            PG8_LDB(B0, 1, 0); PG8_SCHED; PG8_LDA(At, 1, 0); PG8_STAGE(PG8_SA(0, 1), a2 + hstep, voffA);
            PG8_WAIT_L(8); PG8_BAR; PG8_WAIT_L(0); PG8_MMA(0, 0, At, B0); PG8_BAR; PG8_SCHED;
            PG8_LDB(B1, 1, 1); PG8_STAGE(PG8_SB(1, 0), b3, voffB);
            PG8_BAR; PG8_WAIT_L(0); PG8_MMA(0, 1, At, B1); PG8_BAR;
            PG8_LDA(At, 1, 1); PG8_STAGE(PG8_SA(1, 0), a3, voffA);
            PG8_BAR; PG8_WAIT_L(0); PG8_MMA(1, 0, At, B0); PG8_BAR; PG8_SCHED;
            PG8_STAGE(PG8_SB(1, 1), b3 + hstep, voffB);
            PG8_WAIT_V(6); PG8_BAR; PG8_MMA(1, 1, At, B1); PG8_BAR;
        }
        PG8_STAMP();
        if constexpr (!Epi::AFTER_DRAIN) { E(acc, cur, wr, wc, fr, fq); S.done(cur); }
        PG8_STAMP();
        if (!has_next) break;
#pragma unroll
        for (int a = 0; a < 2; ++a)
#pragma unroll
            for (int b = 0; b < 2; ++b)
#pragma unroll
                for (int m = 0; m < 4; ++m)
#pragma unroll
                    for (int n = 0; n < 2; ++n) acc[a][b][m][n] = (f32x4){0.f, 0.f, 0.f, 0.f};
        cur = nxt; cA = nA; cB = nB; ++ui;
    }
    PG8_WAIT_V(0);
    if (wr == 0) PG8_BAR;
    PG8_BAR;
    if constexpr (Epi::AFTER_DRAIN) { E.fused(acc, cur, wr, wc, fr, fq, lds, wid, lane); S.done(cur); }
    PG8_STAMP();
    if (STAMP && wid == 0) { stamps[lane] = lane < nts ? (((unsigned long long)(unsigned)ts_hi << 32) | (unsigned)ts_lo) : 0ull;
        if (lane == 62) stamps[62] = rt_entry; if (lane == 63) stamps[63] = (unsigned long long)wall_clock64(); }
#undef PG8_STAMP
#undef PG8_SA
#undef PG8_SB
#undef PG8_STAGE
#undef PG8_LDA
#undef PG8_LDB
#undef PG8_MMA
#undef PG8_WAIT_V
#undef PG8_WAIT_L
#undef PG8_BAR
#undef PG8_SCHED
}
}

using pg8::bf16_t; using pg8::bf16x8; using pg8::f32x4; using pg8::u32x4; using pg8::cvt_pk_bf16; using pg8::Unit;
#define LAS __attribute__((address_space(3)))
typedef unsigned u32x2 __attribute__((ext_vector_type(2)));

constexpr int D = 1024, NBATCH = 16, SEQ = 2048, CTXL = 256, DEPTH = 4, DIN = 3344, NP = 3328, DFF = 2816;
constexpr int RLAT = NBATCH * SEQ, RCTX = NBATCH * CTXL, ROWS = RLAT + RCTX;
constexpr int PK = 0, PV = 512, PQ = 1024, PO = 1536, PCB = 2048, PCC = 2304, PCH = 2560, PGU = 2816, PGV = 3072;
constexpr float EPS = 1e-6f;
constexpr int LDS_BYTES = 147456;
constexpr int NPHASE = 2 + 8 * DEPTH;
constexpr size_t WS_CTXW = 0;
constexpr size_t WS_ACT = WS_CTXW + (size_t)RCTX * D * 4;
constexpr size_t WS_PBUF = WS_ACT + (size_t)ROWS * D * 2;
constexpr size_t WS_HB = WS_PBUF + (size_t)ROWS * NP * 2;
constexpr size_t WS_GATES = WS_HB + (size_t)ROWS * 512 * 2;
constexpr size_t WS_MOD = WS_GATES + (size_t)ROWS * 16 * 4;
constexpr size_t WS_WB = WS_MOD + (size_t)DEPTH * 17 * 6144 * 4;
constexpr size_t WL_IN = 0, WL_OUT = (size_t)NP * D, WL_13 = WL_OUT + (size_t)D * D, WL_2 = WL_13 + (size_t)2 * DFF * D, WL_SZ = WL_2 + (size_t)D * DFF;
constexpr size_t WS_BAR = WS_WB + (size_t)DEPTH * WL_SZ * 2;
constexpr size_t WS_END = WS_BAR + 16384;

struct Params { const float* in[20]; float* out; unsigned char* ws; };

__device__ __forceinline__ float bflo(unsigned u) { return __uint_as_float(u << 16); }
__device__ __forceinline__ float bfhi(unsigned u) { return __uint_as_float(u & 0xffff0000u); }
__device__ __forceinline__ float bf2f(short v) { return __uint_as_float(((unsigned)(unsigned short)v) << 16); }
__device__ __forceinline__ f32x4 mfma16(bf16x8 a, bf16x8 b, f32x4 c) { return __builtin_amdgcn_mfma_f32_16x16x32_bf16(a, b, c, 0, 0, 0); }
__device__ __forceinline__ float silu_f(float a) { return a * __builtin_amdgcn_rcpf(1.f + __expf(-a)); }

struct EpiP {
    static constexpr bool PERM = true, AFTER_DRAIN = false;
    bf16_t* O; int ldc;
    __device__ __forceinline__ void operator()(const f32x4 (&acc)[2][2][4][2], const Unit& u, int wr, int wc, int fr, int fq) const {
        const int row0 = u.pm * 256 + wr * 64 + fr, col0 = u.pn * 256 + wc * 32 + 8 * fq;
#pragma unroll
        for (int ai = 0; ai < 2; ++ai)
#pragma unroll
            for (int m = 0; m < 4; ++m) { bf16_t* rowp = O + (size_t)(row0 + ai * 128 + m * 16) * ldc + col0;
#pragma unroll
                for (int bj = 0; bj < 2; ++bj) { const f32x4 v0 = acc[ai][bj][m][0], v1 = acc[ai][bj][m][1];
                    u32x4 w; w.x = cvt_pk_bf16(v0[0], v0[1]); w.y = cvt_pk_bf16(v0[2], v0[3]); w.z = cvt_pk_bf16(v1[0], v1[1]); w.w = cvt_pk_bf16(v1[2], v1[3]);
                    *(u32x4*)(rowp + bj * 128) = w; } }
    }
};
struct EpiSwiglu {
    static constexpr bool PERM = true, AFTER_DRAIN = false;
    bf16_t* O;
    __device__ __forceinline__ void operator()(const f32x4 (&acc)[2][2][4][2], const Unit& u, int wr, int wc, int fr, int fq) const {
        const int row0 = u.pm * 256 + wr * 64 + fr, col0 = u.pn * 128 + wc * 32 + 8 * fq;
#pragma unroll
        for (int ai = 0; ai < 2; ++ai)
#pragma unroll
            for (int m = 0; m < 4; ++m) { bf16_t* rowp = O + (size_t)(row0 + ai * 128 + m * 16) * DFF + col0;
                const f32x4 a0 = acc[ai][0][m][0], a1 = acc[ai][0][m][1], b0 = acc[ai][1][m][0], b1 = acc[ai][1][m][1];
                u32x4 w;
                w.x = cvt_pk_bf16(silu_f(a0[0]) * b0[0], silu_f(a0[1]) * b0[1]); w.y = cvt_pk_bf16(silu_f(a0[2]) * b0[2], silu_f(a0[3]) * b0[3]);
                w.z = cvt_pk_bf16(silu_f(a1[0]) * b1[0], silu_f(a1[1]) * b1[1]); w.w = cvt_pk_bf16(silu_f(a1[2]) * b1[2], silu_f(a1[3]) * b1[3]);
                *(u32x4*)rowp = w; }
    }
};
struct EpiResid {
    static constexpr bool PERM = false, AFTER_DRAIN = false;
    float* xl; float* xc; const float* modl; int goff;
    __device__ __forceinline__ void operator()(const f32x4 (&acc)[2][2][4][2], const Unit& u, int wr, int wc, int fr, int fq) const {
        const int row0 = u.pm * 256 + wr * 64 + fr, col0 = u.pn * 256 + wc * 32 + 4 * fq;
        float* X = u.pm < 128 ? xl + (size_t)row0 * D : xc + (size_t)(row0 - RLAT) * D;
        const float* gp = modl + (size_t)(u.pm < 128 ? (u.pm >> 3) : 16) * 6144 + goff + col0;
        f32x4 gv[2][2];
#pragma unroll
        for (int bj = 0; bj < 2; ++bj)
#pragma unroll
            for (int n = 0; n < 2; ++n) gv[bj][n] = *(const f32x4*)(gp + bj * 128 + n * 16);
#pragma unroll
        for (int ai = 0; ai < 2; ++ai)
#pragma unroll
            for (int m = 0; m < 4; ++m) { float* rowp = X + (size_t)(ai * 128 + m * 16) * D + col0;
#pragma unroll
                for (int bj = 0; bj < 2; ++bj)
#pragma unroll
                    for (int n = 0; n < 2; ++n) { f32x4 xv = *(f32x4*)(rowp + bj * 128 + n * 16); xv += gv[bj][n] * acc[ai][bj][m][n]; *(f32x4*)(rowp + bj * 128 + n * 16) = xv; } }
    }
};

__device__ void phase_prep(const Params& p, LAS unsigned char* lds) {
    const int tid = tid_l(), w = tid >> 6, lane = tid & 63;
    float* MOD = (float*)(p.ws + WS_MOD);
    {
        LAS float* S = (LAS float*)lds;
        LAS float* R = S + 17 * 1024;
        for (int i = tid; i < 17 * 1024; i += 512) { const int r = i >> 10, k = i & 1023; const float v = r < 16 ? p.in[1][r * 1024 + k] : p.in[3][k]; S[i] = v / (1.f + expf(-v)); }
        __syncthreads();
        for (int item = bid_l(); item < 384; item += gridDim.x) {
            const int l = item / 96, n0 = (item % 96) * 64;
            const float* wa = p.in[4] + (size_t)l * 1024 * 6144 + n0 + lane;
            float acc[17];
#pragma unroll
            for (int r = 0; r < 17; ++r) acc[r] = 0.f;
            for (int k4 = 0; k4 < 32; ++k4) {
                const int k = w * 128 + k4 * 4;
                const float w0 = wa[(size_t)k * 6144], w1 = wa[(size_t)(k + 1) * 6144], w2 = wa[(size_t)(k + 2) * 6144], w3 = wa[(size_t)(k + 3) * 6144];
#pragma unroll
                for (int r = 0; r < 17; ++r) { const f32x4 s = *(const LAS f32x4*)(S + r * 1024 + k); acc[r] += s[0] * w0 + s[1] * w1 + s[2] * w2 + s[3] * w3; }
            }
#pragma unroll
            for (int r = 0; r < 17; ++r) R[(w * 17 + r) * 64 + lane] = acc[r];
            __syncthreads();
            for (int o = tid; o < 17 * 64; o += 512) { const int r = o >> 6, n = o & 63; float s = 0.f;
#pragma unroll
                for (int ww = 0; ww < 8; ++ww) s += R[(ww * 17 + r) * 64 + n];
                MOD[((size_t)l * 17 + r) * 6144 + n0 + n] = s + p.in[5][l * 6144 + n0 + n]; }
            __syncthreads();
        }
    }
    {
        LAS float* T = (LAS float*)lds;
        for (int item = bid_l(); item < DEPTH * 3200; item += gridDim.x) {
            const int l = item / 3200; int j = item % 3200;
            bf16_t* WB = (bf16_t*)(p.ws + WS_WB) + (size_t)l * WL_SZ;
            const float* src; int ld, col0, k0, K; bf16_t* dst; float scale = 1.f;
            if (j < 832) { const int n0 = (j >> 4) * 64; k0 = (j & 15) * 64; src = p.in[8] + (size_t)l * D * DIN; ld = DIN; col0 = n0 < 1024 ? n0 : n0 + 16; K = D; dst = WB + WL_IN + (size_t)n0 * D; if (n0 < 512) scale = 0.08838834764831845f; }
            else if (j < 1088) { j -= 832; const int n0 = (j >> 4) * 64; k0 = (j & 15) * 64; src = p.in[15] + (size_t)l * D * D; ld = D; col0 = n0; K = D; dst = WB + WL_OUT + (size_t)n0 * D; }
            else if (j < 2496) { j -= 1088; const int n0 = (j >> 4) * 64; k0 = (j & 15) * 64; const int pn = n0 >> 8, bj = (n0 >> 7) & 1, r0 = n0 & 127;
                src = (bj ? p.in[17] : p.in[16]) + (size_t)l * D * DFF; ld = DFF; col0 = pn * 128 + r0; K = D; dst = WB + WL_13 + (size_t)n0 * D; }
            else { j -= 2496; const int n0 = (j / 44) * 64; k0 = (j % 44) * 64; src = p.in[18] + (size_t)l * DFF * D; ld = D; col0 = n0; K = DFF; dst = WB + WL_2 + (size_t)n0 * DFF; }
#pragma unroll
            for (int hh = 0; hh < 2; ++hh) { const int k = (tid >> 4) + 32 * hh, n4 = (tid & 15) * 4;
                const f32x4 v = *(const f32x4*)(src + (size_t)(k0 + k) * ld + col0 + n4);
                T[k * 65 + n4] = v[0] * scale; T[k * 65 + n4 + 1] = v[1] * scale; T[k * 65 + n4 + 2] = v[2] * scale; T[k * 65 + n4 + 3] = v[3] * scale; }
            __syncthreads();
            { const int n = tid >> 3, k8 = (tid & 7) * 8; u32x4 o;
                o.x = cvt_pk_bf16(T[(k8 + 0) * 65 + n], T[(k8 + 1) * 65 + n]); o.y = cvt_pk_bf16(T[(k8 + 2) * 65 + n], T[(k8 + 3) * 65 + n]);
                o.z = cvt_pk_bf16(T[(k8 + 4) * 65 + n], T[(k8 + 5) * 65 + n]); o.w = cvt_pk_bf16(T[(k8 + 6) * 65 + n], T[(k8 + 7) * 65 + n]);
                *(u32x4*)(dst + (size_t)n * K + k0 + k8) = o; }
            __syncthreads();
        }
    }
    {
        const f32x4* xs = (const f32x4*)p.in[0]; f32x4* xd = (f32x4*)p.out;
        for (size_t i = (size_t)bid_l() * 512 + tid; i < (size_t)RLAT * D / 4; i += (size_t)gridDim.x * 512) xd[i] = xs[i];
        const f32x4* cs = (const f32x4*)p.in[2]; f32x4* cd = (f32x4*)(p.ws + WS_CTXW);
        for (size_t i = (size_t)bid_l() * 512 + tid; i < (size_t)RCTX * D / 4; i += (size_t)gridDim.x * 512) cd[i] = cs[i];
    }
}

template <int MODE> __device__ void phase_norm(const Params& p, int l, int nrows, LAS unsigned char* lds) {
    const int tid = tid_l(), w = tid >> 6, lane = tid & 63;
    LAS float* Wgt = (LAS float*)lds;
    if (MODE == 0) { const float* wi = p.in[8] + (size_t)l * D * DIN + 1024;
        for (int i = tid; i < 16384; i += 512) { const int k = i >> 4, n = i & 15; Wgt[n * 1024 + k] = wi[(size_t)k * DIN + n]; }
        __syncthreads(); }
    const float* nw = MODE == 0 ? p.in[6] + l * D : (MODE == 1 ? p.in[7] + l * D : p.in[19]);
    const float* MOD = (const float*)(p.ws + WS_MOD) + (size_t)l * 17 * 6144;
    bf16_t* ACT = (bf16_t*)(p.ws + WS_ACT); float* GATES = (float*)(p.ws + WS_GATES); float* CTXW = (float*)(p.ws + WS_CTXW);
    f32x4 nv[4];
#pragma unroll
    for (int j = 0; j < 4; ++j) nv[j] = *(const f32x4*)(nw + j * 256 + lane * 4);
    for (int row = bid_l() * 8 + w; row < nrows; row += gridDim.x * 8) {
        float* xr = row < RLAT ? p.out + (size_t)row * D : CTXW + (size_t)(row - RLAT) * D;
        f32x4 xv[4]; float ss = 0.f;
#pragma unroll
        for (int j = 0; j < 4; ++j) { xv[j] = *(const f32x4*)(xr + j * 256 + lane * 4); ss += xv[j][0] * xv[j][0] + xv[j][1] * xv[j][1] + xv[j][2] * xv[j][2] + xv[j][3] * xv[j][3]; }
#pragma unroll
        for (int o = 32; o >= 1; o >>= 1) ss += __shfl_xor(ss, o);
        const float rstd = rsqrtf(ss * (1.f / 1024.f) + EPS);
        if (MODE == 2) {
#pragma unroll
            for (int j = 0; j < 4; ++j) *(f32x4*)(xr + j * 256 + lane * 4) = xv[j] * rstd * nv[j];
            continue;
        }
        const float* mr = MOD + (size_t)(row < RLAT ? (row >> 11) : 16) * 6144 + (MODE == 0 ? 0 : 3072);
        f32x4 y[4];
#pragma unroll
        for (int j = 0; j < 4; ++j) { const f32x4 sh = *(const f32x4*)(mr + j * 256 + lane * 4), scl = *(const f32x4*)(mr + 1024 + j * 256 + lane * 4);
            y[j] = xv[j] * rstd * nv[j] * (scl + 1.f) + sh;
            u32x2 o; o.x = cvt_pk_bf16(y[j][0], y[j][1]); o.y = cvt_pk_bf16(y[j][2], y[j][3]);
            *(u32x2*)(ACT + (size_t)row * D + j * 256 + lane * 4) = o; }
        if (MODE == 0) {
            float gv[16];
#pragma unroll
            for (int n = 0; n < 16; ++n) { float f = 0.f;
#pragma unroll
                for (int j = 0; j < 4; ++j) { const f32x4 wv = *(const LAS f32x4*)(Wgt + n * 1024 + j * 256 + lane * 4); f += y[j][0] * wv[0] + y[j][1] * wv[1] + y[j][2] * wv[2] + y[j][3] * wv[3]; }
                gv[n] = f; }
            { const bool hi = lane & 32;
#pragma unroll
                for (int i = 0; i < 8; ++i) { const float send = hi ? gv[i] : gv[i + 8], keep = hi ? gv[i + 8] : gv[i]; gv[i] = keep + __shfl_xor(send, 32); } }
            { const bool hi = lane & 16;
#pragma unroll
                for (int i = 0; i < 4; ++i) { const float send = hi ? gv[i] : gv[i + 4], keep = hi ? gv[i + 4] : gv[i]; gv[i] = keep + __shfl_xor(send, 16); } }
            { const bool hi = lane & 8;
#pragma unroll
                for (int i = 0; i < 2; ++i) { const float send = hi ? gv[i] : gv[i + 2], keep = hi ? gv[i + 2] : gv[i]; gv[i] = keep + __shfl_xor(send, 8); } }
            { const bool hi = lane & 4; const float send = hi ? gv[0] : gv[1], keep = hi ? gv[1] : gv[0]; gv[0] = keep + __shfl_xor(send, 4); }
            gv[0] += __shfl_xor(gv[0], 2); gv[0] += __shfl_xor(gv[0], 1);
            const int n = (lane >> 2) & 15;
            if ((lane & 3) == 0) GATES[(size_t)row * 16 + n] = gv[0] + p.in[9][l * 16 + n];
        }
    }
}

__device__ void chain_item(const Params& p, int item, bool last, LAS unsigned char* lds) {
    const int tid = tid_l(), w = tid >> 6, lane = tid & 63, fr = lane & 15, fq = lane >> 4;
    const int vh = item & 1, dir = (item >> 1) & 1, h = (item >> 2) & 3, b = item >> 4;
    constexpr int RS = 136;
    LAS bf16_t* Qs = (LAS bf16_t*)lds;
    LAS bf16_t* Kw = Qs + 128 * RS;
    LAS bf16_t* Kwt = Kw + 128 * RS;
    LAS bf16_t* Vt = Kwt + 128 * RS;
    LAS bf16_t* Ct = Vt + 64 * RS;
    LAS float* sc = (LAS float*)(Ct + 64 * RS);
    LAS float *s_lf = sc, *s_li = sc + 128, *s_ws = sc + 256, *s_g = sc + 384, *s_in = sc + 512, *s_em = sc + 640, *s_nv = sc + 768, *s_misc = sc + 896;
    const bf16_t* PB = (const bf16_t*)(p.ws + WS_PBUF); const float* GATES = (const float*)(p.ws + WS_GATES);
    bf16_t* ACT = (bf16_t*)(p.ws + WS_ACT); bf16_t* HB = (bf16_t*)(p.ws + WS_HB);
    for (int i = tid; i < 64 * RS / 2; i += 512) ((LAS unsigned*)Ct)[i] = 0u;
    if (tid < 128) s_nv[tid] = 0.f;
    f32x4 cacc[4];
#pragma unroll
    for (int x = 0; x < 4; ++x) cacc[x] = (f32x4){0.f, 0.f, 0.f, 0.f};
    float nreg = 0.f, m_st = 0.f;
    u32x4 qreg[4], kreg[4], vreg[2];
#define CHUNK_BASE(s) (dir == 0 ? ((s) < 2 ? RLAT + b * CTXL + 128 * (s) : b * SEQ + 128 * ((s) - 2)) : ((s) < 2 ? RLAT + b * CTXL + 128 * (1 - (s)) : b * SEQ + 128 * (17 - (s))))
#define LOAD_CHUNK(s) do { const int _base = CHUNK_BASE(s); \
        _Pragma("unroll") for (int e = 0; e < 4; ++e) { const int _row = e * 32 + (tid >> 4); const int _tok = _base + (dir ? 127 - _row : _row); \
            const bf16_t* _pr = PB + (size_t)_tok * NP + 128 * h + (tid & 15) * 8; qreg[e] = *(const u32x4*)(_pr + PQ); kreg[e] = *(const u32x4*)(_pr + PK); } \
        _Pragma("unroll") for (int e = 0; e < 2; ++e) { const int _idx = e * 512 + tid; const int _row = _idx >> 3; const int _tok = _base + (dir ? 127 - _row : _row); \
            vreg[e] = *(const u32x4*)(PB + (size_t)_tok * NP + PV + 128 * h + 64 * vh + (_idx & 7) * 8); } } while (0)
    LOAD_CHUNK(0);
    for (int s = 0; s < 18; ++s) {
        const int base = CHUNK_BASE(s);
        if (tid < 128) { const int tok = base + (dir ? 127 - tid : tid); const float* g = GATES + (size_t)tok * 16 + dir * 8 + h;
            const float gi = g[0], gf = g[4]; s_li[tid] = gi; s_lf[tid] = fminf(gf, 0.f) - log1pf(expf(-fabsf(gf))); }
#pragma unroll
        for (int e = 0; e < 4; ++e) { const int row = e * 32 + (tid >> 4), c8 = (tid & 15) * 8; *(LAS u32x4*)(Qs + row * RS + c8) = qreg[e]; }
#pragma unroll
        for (int e = 0; e < 2; ++e) { const int idx = e * 512 + tid, row = idx >> 3, c8 = (idx & 7) * 8;
#pragma unroll
            for (int x = 0; x < 4; ++x) { const unsigned u = vreg[e][x]; Vt[(c8 + 2 * x) * RS + row] = (bf16_t)(u & 0xffffu); Vt[(c8 + 2 * x + 1) * RS + row] = (bf16_t)(u >> 16); } }
        __syncthreads();
        if (w == 0) {
            const float l0 = s_lf[2 * lane], l1 = s_lf[2 * lane + 1], i0 = s_li[2 * lane], i1 = s_li[2 * lane + 1];
            float incl = l0 + l1;
#pragma unroll
            for (int off = 1; off < 64; off <<= 1) { const float tv = __shfl_up(incl, off); if (lane >= off) incl += tv; }
            const float b1 = incl, b0 = incl - l1;
            const float a0 = i0 - b0, a1 = i1 - b1;
            float mx = fmaxf(a0, a1);
#pragma unroll
            for (int off = 1; off < 64; off <<= 1) { const float tv = __shfl_up(mx, off); if (lane >= off) mx = fmaxf(mx, tv); }
            float ex = __shfl_up(mx, 1); if (lane == 0) ex = -INFINITY;
            const float c0 = fmaxf(m_st, fmaxf(ex, a0)), c1 = fmaxf(m_st, mx);
            const float c127 = __shfl(c1, 63), b127 = __shfl(b1, 63);
            s_ws[2 * lane] = expf(a0 - c127); s_ws[2 * lane + 1] = expf(a1 - c127);
            s_g[2 * lane] = expf(c127 - c0); s_g[2 * lane + 1] = expf(c127 - c1);
            s_in[2 * lane] = expf(m_st - c0); s_in[2 * lane + 1] = expf(m_st - c1);
            s_em[2 * lane] = expf(-(b0 + c0)); s_em[2 * lane + 1] = expf(-(b1 + c1));
            if (lane == 0) s_misc[0] = expf(m_st - c127);
            m_st = b127 + c127;
        }
        __syncthreads();
#pragma unroll
        for (int e = 0; e < 4; ++e) { const int row = e * 32 + (tid >> 4), c8 = (tid & 15) * 8; const float wv = s_ws[row]; u32x4 o;
#pragma unroll
            for (int x = 0; x < 4; ++x) { const unsigned u = kreg[e][x]; const unsigned pk = cvt_pk_bf16(bflo(u) * wv, bfhi(u) * wv); o[x] = pk;
                Kwt[(c8 + 2 * x) * RS + row] = (bf16_t)(pk & 0xffffu); Kwt[(c8 + 2 * x + 1) * RS + row] = (bf16_t)(pk >> 16); }
            *(LAS u32x4*)(Kw + row * RS + c8) = o; }
        if (s + 1 < 18) LOAD_CHUNK(s + 1);
        __syncthreads();
        const int t = 16 * w + fr;
        bf16x8 qa[4];
#pragma unroll
        for (int kk = 0; kk < 4; ++kk) qa[kk] = *(const LAS bf16x8*)(Qs + t * RS + 32 * kk + 8 * fq);
        float qn = 0.f;
#pragma unroll
        for (int kk = 0; kk < 4; ++kk) { const f32x4 n0 = *(const LAS f32x4*)(s_nv + 32 * kk + 8 * fq), n1 = *(const LAS f32x4*)(s_nv + 32 * kk + 8 * fq + 4);
            qn += bf2f(qa[kk][0]) * n0[0] + bf2f(qa[kk][1]) * n0[1] + bf2f(qa[kk][2]) * n0[2] + bf2f(qa[kk][3]) * n0[3]
                + bf2f(qa[kk][4]) * n1[0] + bf2f(qa[kk][5]) * n1[1] + bf2f(qa[kk][6]) * n1[2] + bf2f(qa[kk][7]) * n1[3]; }
        qn += __shfl_xor(qn, 16); qn += __shfl_xor(qn, 32);
        float rs = 0.f;
#pragma unroll
        for (int n = 0; n < 8; ++n) { f32x4 sa = (f32x4){0.f, 0.f, 0.f, 0.f};
#pragma unroll
            for (int kk = 0; kk < 4; ++kk) { const bf16x8 kb = *(const LAS bf16x8*)(Kw + (16 * n + fr) * RS + 32 * kk + 8 * fq); sa = mfma16(kb, qa[kk], sa); }
#pragma unroll
            for (int r = 0; r < 4; ++r) { const int s_ = 16 * n + 4 * fq + r; sa[r] = (s_ <= t) ? sa[r] : 0.f; rs += sa[r]; }
            u32x2 pk; pk.x = cvt_pk_bf16(sa[0], sa[1]); pk.y = cvt_pk_bf16(sa[2], sa[3]);
            *(LAS u32x2*)(Qs + t * RS + 16 * n + 4 * fq) = pk; }
        rs += __shfl_xor(rs, 16); rs += __shfl_xor(rs, 32);
        f32x4 u1[4], u2[4];
#pragma unroll
        for (int jt = 0; jt < 4; ++jt) { u2[jt] = (f32x4){0.f, 0.f, 0.f, 0.f};
#pragma unroll
            for (int kk = 0; kk < 4; ++kk) { const bf16x8 cb = *(const LAS bf16x8*)(Ct + (16 * jt + fr) * RS + 32 * kk + 8 * fq); u2[jt] = mfma16(cb, qa[kk], u2[jt]); } }
        __syncthreads();
        { bf16x8 pb[4];
#pragma unroll
            for (int kk = 0; kk < 4; ++kk) pb[kk] = *(const LAS bf16x8*)(Qs + t * RS + 32 * kk + 8 * fq);
#pragma unroll
            for (int jt = 0; jt < 4; ++jt) { u1[jt] = (f32x4){0.f, 0.f, 0.f, 0.f};
#pragma unroll
                for (int kk = 0; kk < 4; ++kk) { const bf16x8 vb = *(const LAS bf16x8*)(Vt + (16 * jt + fr) * RS + 32 * kk + 8 * fq); u1[jt] = mfma16(vb, pb[kk], u1[jt]); } } }
        if (!(last && s < 2)) {
            const float gt = s_g[t], it = s_in[t], em = s_em[t];
            const float den = gt * rs + it * qn; const float inv = 1.f / fmaxf(fabsf(den), em);
            const int tok = base + (dir ? 127 - t : t);
            bf16_t* dst = (dir == 0 ? ACT + (size_t)tok * D : HB + (size_t)tok * 512) + 128 * h + 64 * vh + 4 * fq;
#pragma unroll
            for (int jt = 0; jt < 4; ++jt) { u32x2 o; o.x = cvt_pk_bf16((gt * u1[jt][0] + it * u2[jt][0]) * inv, (gt * u1[jt][1] + it * u2[jt][1]) * inv);
                o.y = cvt_pk_bf16((gt * u1[jt][2] + it * u2[jt][2]) * inv, (gt * u1[jt][3] + it * u2[jt][3]) * inv);
                *(u32x2*)(dst + 16 * jt) = o; }
        }
        const float decay = s_misc[0];
        const int jt = w & 3, it0 = (w >> 2) * 4;
#pragma unroll
        for (int x = 0; x < 4; ++x) cacc[x] *= decay;
#pragma unroll
        for (int kk = 0; kk < 4; ++kk) { const bf16x8 vb = *(const LAS bf16x8*)(Vt + (16 * jt + fr) * RS + 32 * kk + 8 * fq);
#pragma unroll
            for (int x = 0; x < 4; ++x) { const bf16x8 ka = *(const LAS bf16x8*)(Kwt + (16 * (it0 + x) + fr) * RS + 32 * kk + 8 * fq); cacc[x] = mfma16(ka, vb, cacc[x]); } }
        { const int i = tid >> 2, part = tid & 3; float sum = 0.f;
#pragma unroll
            for (int y = 0; y < 4; ++y) { const bf16x8 v = *(const LAS bf16x8*)(Kwt + i * RS + 32 * part + 8 * y);
                sum += bf2f(v[0]) + bf2f(v[1]) + bf2f(v[2]) + bf2f(v[3]) + bf2f(v[4]) + bf2f(v[5]) + bf2f(v[6]) + bf2f(v[7]); }
            sum += __shfl_xor(sum, 1); sum += __shfl_xor(sum, 2); nreg = decay * nreg + sum; }
        __syncthreads();
#pragma unroll
        for (int x = 0; x < 4; ++x) { u32x2 o; o.x = cvt_pk_bf16(cacc[x][0], cacc[x][1]); o.y = cvt_pk_bf16(cacc[x][2], cacc[x][3]);
            *(LAS u32x2*)(Ct + (16 * jt + fr) * RS + 16 * (it0 + x) + 4 * fq) = o; }
        if ((tid & 3) == 0) s_nv[tid >> 2] = nreg;
    }
    __syncthreads();
#undef LOAD_CHUNK
#undef CHUNK_BASE
}

__device__ void gmlp_item(const Params& p, int l, int ch, LAS unsigned char* lds) {
    const int tid = tid_l(), w = tid >> 6, lane = tid & 63, fr = lane & 15, fq = lane >> 4;
    constexpr int RS = 136;
    LAS bf16_t* vnt = (LAS bf16_t*)lds;
    const bf16_t* PB = (const bf16_t*)(p.ws + WS_PBUF); bf16_t* ACT = (bf16_t*)(p.ws + WS_ACT);
    const int row0 = ch * 128;
    { const int c8 = (tid & 31) * 8; const float* gn = p.in[12] + l * 256 + c8;
        const f32x4 g0 = *(const f32x4*)gn, g1 = *(const f32x4*)(gn + 4);
#pragma unroll
        for (int ps = 0; ps < 8; ++ps) { const int s = ps * 16 + (tid >> 5);
            const u32x4 v = *(const u32x4*)(PB + (size_t)(row0 + s) * NP + PGV + c8);
            float f[8]; f[0] = bflo(v.x); f[1] = bfhi(v.x); f[2] = bflo(v.y); f[3] = bfhi(v.y); f[4] = bflo(v.z); f[5] = bfhi(v.z); f[6] = bflo(v.w); f[7] = bfhi(v.w);
            float ss = 0.f;
#pragma unroll
            for (int x = 0; x < 8; ++x) ss += f[x] * f[x];
#pragma unroll
            for (int o = 16; o >= 1; o >>= 1) ss += __shfl_xor(ss, o);
            const float rstd = rsqrtf(ss * (1.f / 256.f) + EPS);
            const unsigned p0 = cvt_pk_bf16(f[0] * rstd * g0[0], f[1] * rstd * g0[1]), p1 = cvt_pk_bf16(f[2] * rstd * g0[2], f[3] * rstd * g0[3]);
            const unsigned p2 = cvt_pk_bf16(f[4] * rstd * g1[0], f[5] * rstd * g1[1]), p3 = cvt_pk_bf16(f[6] * rstd * g1[2], f[7] * rstd * g1[3]);
            vnt[(c8 + 0) * RS + s] = (bf16_t)(p0 & 0xffffu); vnt[(c8 + 1) * RS + s] = (bf16_t)(p0 >> 16); vnt[(c8 + 2) * RS + s] = (bf16_t)(p1 & 0xffffu); vnt[(c8 + 3) * RS + s] = (bf16_t)(p1 >> 16);
            vnt[(c8 + 4) * RS + s] = (bf16_t)(p2 & 0xffffu); vnt[(c8 + 5) * RS + s] = (bf16_t)(p2 >> 16); vnt[(c8 + 6) * RS + s] = (bf16_t)(p3 & 0xffffu); vnt[(c8 + 7) * RS + s] = (bf16_t)(p3 >> 16); } }
    __syncthreads();
    const int t = 16 * w + fr;
    const size_t grow = (size_t)(row0 + t);
#pragma unroll 1
    for (int g = 0; g < 4; ++g) {
        const float* wsr = p.in[13] + (((size_t)l * 4 + g) * 128 + t) * 128;
        bf16x8 wb[4];
#pragma unroll
        for (int kk = 0; kk < 4; ++kk) { const f32x4 a = *(const f32x4*)(wsr + 32 * kk + 8 * fq), c = *(const f32x4*)(wsr + 32 * kk + 8 * fq + 4);
            u32x4 o; o.x = cvt_pk_bf16(a[0], a[1]); o.y = cvt_pk_bf16(a[2], a[3]); o.z = cvt_pk_bf16(c[0], c[1]); o.w = cvt_pk_bf16(c[2], c[3]);
            wb[kk] = __builtin_bit_cast(bf16x8, o); }
        const float bs = p.in[14][((size_t)l * 4 + g) * 128 + t];
#pragma unroll
        for (int cc = 0; cc < 4; ++cc) { const int ct = 4 * g + cc; f32x4 acc = (f32x4){0.f, 0.f, 0.f, 0.f};
#pragma unroll
            for (int kk = 0; kk < 4; ++kk) { const bf16x8 va = *(const LAS bf16x8*)(vnt + (16 * ct + fr) * RS + 32 * kk + 8 * fq); acc = mfma16(va, wb[kk], acc); }
            const int c = 16 * ct + 4 * fq;
            const u32x2 uu = *(const u32x2*)(PB + grow * NP + PGU + c);
            u32x2 o; o.x = cvt_pk_bf16(bflo(uu.x) * (acc[0] + bs), bfhi(uu.x) * (acc[1] + bs)); o.y = cvt_pk_bf16(bflo(uu.y) * (acc[2] + bs), bfhi(uu.y) * (acc[3] + bs));
            *(u32x2*)(ACT + grow * D + 768 + c) = o; }
    }
    __syncthreads();
}

__device__ void conv_all(const Params& p, int l, int nrows) {
    const bf16_t* PB = (const bf16_t*)(p.ws + WS_PBUF); bf16_t* ACT = (bf16_t*)(p.ws + WS_ACT);
    const float* cw = p.in[11] + (size_t)l * 3 * 256;
    for (int idx = bid_l() * 512 + tid_l(); idx < nrows * 32; idx += gridDim.x * 512) {
        const int row = idx >> 5, c8 = (idx & 31) * 8;
        bool hp, hn;
        if (row < RLAT) { const int pos = row & 63; hp = pos > 0; hn = pos < 63; } else { const int pos = (row - RLAT) & 255; hp = pos > 0; hn = pos < 255; }
        const bf16_t* pr = PB + (size_t)row * NP + c8;
        const u32x4 gb = *(const u32x4*)(pr + PCB);
        const u32x4 c1 = *(const u32x4*)(pr + PCC), h1 = *(const u32x4*)(pr + PCH);
        u32x4 c0 = (u32x4){0u, 0u, 0u, 0u}, h0 = c0, c2 = c0, h2 = c0;
        if (hp) { c0 = *(const u32x4*)(pr - NP + PCC); h0 = *(const u32x4*)(pr - NP + PCH); }
        if (hn) { c2 = *(const u32x4*)(pr + NP + PCC); h2 = *(const u32x4*)(pr + NP + PCH); }
        u32x4 o;
#pragma unroll
        for (int x = 0; x < 4; ++x) {
            const int c = c8 + 2 * x;
            const float ylo = cw[c] * (bflo(c0[x]) * bflo(h0[x])) + cw[256 + c] * (bflo(c1[x]) * bflo(h1[x])) + cw[512 + c] * (bflo(c2[x]) * bflo(h2[x]));
            const float yhi = cw[c + 1] * (bfhi(c0[x]) * bfhi(h0[x])) + cw[256 + c + 1] * (bfhi(c1[x]) * bfhi(h1[x])) + cw[512 + c + 1] * (bfhi(c2[x]) * bfhi(h2[x]));
            o[x] = cvt_pk_bf16(bflo(gb[x]) * ylo, bfhi(gb[x]) * yhi);
        }
        *(u32x4*)(ACT + (size_t)row * D + 512 + c8) = o;
    }
}

__device__ void combine_all(const Params& p, int l, int nrows) {
    const bf16_t* PB = (const bf16_t*)(p.ws + WS_PBUF); bf16_t* ACT = (bf16_t*)(p.ws + WS_ACT); const bf16_t* HB = (const bf16_t*)(p.ws + WS_HB);
    const float* mn = p.in[10] + (size_t)l * 512;
    for (int idx = bid_l() * 512 + tid_l(); idx < nrows * 64; idx += gridDim.x * 512) {
        const int row = idx >> 6, c8 = (idx & 63) * 8;
        const u32x4 a = *(const u32x4*)(ACT + (size_t)row * D + c8), bb = *(const u32x4*)(HB + (size_t)row * 512 + c8), og = *(const u32x4*)(PB + (size_t)row * NP + PO + c8);
        float f[8]; float ss = 0.f;
#pragma unroll
        for (int x = 0; x < 4; ++x) { f[2 * x] = bflo(a[x]) + bflo(bb[x]); f[2 * x + 1] = bfhi(a[x]) + bfhi(bb[x]); ss += f[2 * x] * f[2 * x] + f[2 * x + 1] * f[2 * x + 1]; }
#pragma unroll
        for (int o = 8; o >= 1; o >>= 1) ss += __shfl_xor(ss, o);
        const float rstd = rsqrtf(ss * (1.f / 128.f) + EPS);
        u32x4 o;
#pragma unroll
        for (int x = 0; x < 4; ++x) {
            const float o0 = 1.f / (1.f + __expf(-bflo(og[x]))), o1 = 1.f / (1.f + __expf(-bfhi(og[x])));
            o[x] = cvt_pk_bf16(o0 * f[2 * x] * rstd * mn[c8 + 2 * x], o1 * f[2 * x + 1] * rstd * mn[c8 + 2 * x + 1]);
        }
        *(u32x4*)(ACT + (size_t)row * D + c8) = o;
    }
}

#include <cstdio>
#include <cstdint>
#include <cstdlib>
#include <vector>

#define XB_TMO      128
#define XB_XCNT(j)  (256  + 64 * (j))
#define XB_XSUB(j)  (1280 + 64 * (j))
#define XB_XGEN(j)  (2304 + 64 * (j))
#define XB_TOP      3328
#define XB_TOPGEN   3392
#define XCD_BAR_WORDS 3456
#define XB_SPIN_CAP (1u << 18)

__device__ __forceinline__ unsigned xb_ld(unsigned* p)              { return __hip_atomic_load(p, __ATOMIC_RELAXED, __HIP_MEMORY_SCOPE_AGENT); }
__device__ __forceinline__ unsigned xb_add(unsigned* p, unsigned v) { return __hip_atomic_fetch_add(p, v, __ATOMIC_RELAXED, __HIP_MEMORY_SCOPE_AGENT); }
__device__ __forceinline__ unsigned xb_xcc_id() { return (unsigned)__builtin_amdgcn_s_getreg((3 << 11) | 20) & 0xFu; }
#define XB_SPIN(cond, bar) do { unsigned _sp = 0; while (cond) { __builtin_amdgcn_s_sleep(1); \
    if ((++_sp & 255u) == 0u) { if (xb_ld(&(bar)[XB_TMO])) break; if (_sp > XB_SPIN_CAP) { atomicAdd(&(bar)[XB_TMO], 1u); break; } } } } while (0)

struct XcdBarrier {
    unsigned* bar; unsigned x;
    volatile LAS unsigned* st;
};

__device__ __forceinline__ XcdBarrier xcd_barrier_post(unsigned* bar, volatile LAS unsigned* st) {
    XcdBarrier b; b.bar = bar; b.x = xb_xcc_id(); b.st = st;
    if (threadIdx.x == 0) (void)xb_add(&bar[XB_XCNT(b.x)], 1u);
    return b;
}
__device__ __forceinline__ void xcd_barrier_complete(unsigned* bar, unsigned x, unsigned& nloc, unsigned& nx) {
    const unsigned G = gridDim.x * gridDim.y * gridDim.z;
    unsigned sum, cnt, mine, sp = 0u;
    for (;;) {
        sum = 0u; cnt = 0u; mine = 0u;
#pragma unroll
        for (unsigned j = 0; j < 16; ++j) { const unsigned c = xb_ld(&bar[XB_XCNT(j)]); sum += c; cnt += (c > 0u) ? 1u : 0u; mine = (j == x) ? c : mine; }
        if (sum == G) break;
        __builtin_amdgcn_s_sleep(1);
        if ((++sp & 255u) == 0u) { if (xb_ld(&bar[XB_TMO])) break; if (sp > XB_SPIN_CAP) { atomicAdd(&bar[XB_TMO], 1u); break; } }
    }
    nloc = mine > 0u ? mine : 1u; nx = cnt > 0u ? cnt : 1u;
}

__device__ __forceinline__ void xcd_barrier(const XcdBarrier& b) {
    asm volatile("s_waitcnt vmcnt(0)" ::: "memory");
    __syncthreads();
    if (threadIdx.x == 0) {
        unsigned* bar = b.bar;
        __builtin_amdgcn_s_waitcnt(0);
        unsigned nloc = b.st[0], nx = b.st[1];
        if (nloc == 0u) { xcd_barrier_complete(bar, b.x, nloc, nx); b.st[0] = nloc; b.st[1] = nx; }
        const unsigned old = xb_add(&bar[XB_XSUB(b.x)], 1u);
        const unsigned gen = old / nloc;
        if (old + 1u == (gen + 1u) * nloc) {
            __builtin_amdgcn_fence(__ATOMIC_RELEASE, "agent");
            asm volatile("s_waitcnt vmcnt(0)" ::: "memory");
            const unsigned og = xb_add(&bar[XB_TOP], 1u);
            const unsigned tg = og / nx;
            if (og + 1u == (tg + 1u) * nx) xb_add(&bar[XB_TOPGEN], 1u);
            else XB_SPIN(xb_ld(&bar[XB_TOPGEN]) == tg, bar);
            __builtin_amdgcn_fence(__ATOMIC_ACQUIRE, "agent");
            xb_add(&bar[XB_XGEN(b.x)], 1u);
            asm volatile("s_waitcnt vmcnt(0)" ::: "memory");
        } else {
            XB_SPIN(xb_ld(&bar[XB_XGEN(b.x)]) == gen, bar);
            __builtin_amdgcn_fence(__ATOMIC_ACQUIRE, "agent");
            asm volatile("s_waitcnt vmcnt(0)" ::: "memory");
        }
    }
    __syncthreads();
}


__device__ __forceinline__ void run_phase(const Params& p, int ph, LAS unsigned char* lds) {
    if (ph == 0) { phase_prep(p, lds); return; }
    if (ph == NPHASE - 1) { phase_norm<2>(p, 0, RLAT, lds); return; }
    const int l = (ph - 1) >> 3, sub = (ph - 1) & 7; const bool last = (l == DEPTH - 1);
    const int nrows = last ? RLAT : ROWS;
    bf16_t* ACT = (bf16_t*)(p.ws + WS_ACT); bf16_t* PBUF = (bf16_t*)(p.ws + WS_PBUF);
    const bf16_t* WB = (const bf16_t*)(p.ws + WS_WB) + (size_t)l * WL_SZ;
    pg8::StaticOrder S;
    if (sub == 0) { phase_norm<0>(p, l, ROWS, lds); }
    else if (sub == 1) { pg8::Gemm g; g.A = ACT; g.Bt = WB + WL_IN; g.M = ROWS; g.N = NP; g.K = D; S.init(g.M, g.N, (int)gridDim.x, (int)bid_l());
        EpiP E; E.O = PBUF; E.ldc = NP; pg8::gemm_phase<EpiP, pg8::StaticOrder, false>(lds, g, S, E, nullptr); }
    else if (sub == 2) {
        for (int item = bid_l(); item < 256; item += gridDim.x) chain_item(p, item, last, lds);
        for (int ch = bid_l(); ch < nrows / 128; ch += gridDim.x) gmlp_item(p, l, ch, lds);
        conv_all(p, l, nrows);
    }
    else if (sub == 3) { combine_all(p, l, nrows); }
    else if (sub == 4 || sub == 7) { pg8::Gemm g; g.M = nrows; g.N = D;
        if (sub == 4) { g.A = ACT; g.Bt = WB + WL_OUT; g.K = D; } else { g.A = PBUF; g.Bt = WB + WL_2; g.K = DFF; }
        S.init(g.M, g.N, (int)gridDim.x, (int)bid_l());
        EpiResid E; E.xl = p.out; E.xc = (float*)(p.ws + WS_CTXW); E.modl = (const float*)(p.ws + WS_MOD) + (size_t)l * 17 * 6144; E.goff = sub == 4 ? 2048 : 5120;
        pg8::gemm_phase<EpiResid, pg8::StaticOrder, false>(lds, g, S, E, nullptr); }
    else if (sub == 5) { phase_norm<1>(p, l, nrows, lds); }
    else { pg8::Gemm g; g.A = ACT; g.Bt = WB + WL_13; g.M = nrows; g.N = 2 * DFF; g.K = D; S.init(g.M, g.N, (int)gridDim.x, (int)bid_l());
        EpiSwiglu E; E.O = PBUF; pg8::gemm_phase<EpiSwiglu, pg8::StaticOrder, false>(lds, g, S, E, nullptr); }
}

__global__ void __launch_bounds__(512, 2) fwd_kernel(Params p, int ph_lo, int ph_hi) {
    extern __shared__ __attribute__((aligned(16))) unsigned char shm[];
    LAS unsigned char* lds = (LAS unsigned char*)shm;
    cg::grid_group grid = cg::this_grid();
    volatile LAS unsigned* st = (volatile LAS unsigned*)(lds + LDS_BYTES - 16);
    if (threadIdx.x == 0) { st[0] = 0u; st[1] = 0u; }
    __syncthreads();
    const XcdBarrier xb = xcd_barrier_post((unsigned*)(p.ws + WS_BAR), st);
    for (int ph = ph_lo; ph < ph_hi; ++ph) {
        run_phase(p, ph, lds);
        if (ph + 1 < ph_hi) { if (ph == ph_lo) grid.sync(); else xcd_barrier(xb); }
    }
}

extern "C" void kernel_launch(void* const* d_in, const int* in_sizes, int n_in, void* d_out, int out_size, void* d_ws, size_t ws_size, hipStream_t stream) {
    static int grid = 0;
    if (grid == 0) {
        if (n_in != 20 || out_size != RLAT * D || ws_size < WS_END) { fprintf(stderr, "kernel_launch: unexpected shapes (n_in %d, out %d, ws %zu, need %zu)\n", n_in, out_size, ws_size, (size_t)WS_END); grid = -1; return; }
        int dev = 0, cus = 0, per_cu = 0;
        (void)hipGetDevice(&dev); (void)hipDeviceGetAttribute(&cus, hipDeviceAttributeMultiprocessorCount, dev);
        if (hipFuncSetAttribute((const void*)fwd_kernel, hipFuncAttributeMaxDynamicSharedMemorySize, LDS_BYTES) != hipSuccess) { fprintf(stderr, "kernel_launch: hipFuncSetAttribute failed\n"); grid = -1; return; }
        if (hipOccupancyMaxActiveBlocksPerMultiprocessor(&per_cu, (const void*)fwd_kernel, 512, LDS_BYTES) != hipSuccess || per_cu < 1) { fprintf(stderr, "kernel_launch: occupancy query failed (%d)\n", per_cu); (void)hipGetLastError(); per_cu = 1; }
        grid = cus * per_cu;
    }
    if (grid < 0) return;
    if (hipMemsetAsync((char*)d_ws + WS_BAR, 0, 16384, stream) != hipSuccess) { fprintf(stderr, "kernel_launch: memset of barrier words failed\n"); return; }
    Params p{};
    for (int i = 0; i < 20; ++i) p.in[i] = (const float*)d_in[i];
    p.out = (float*)d_out; p.ws = (unsigned char*)d_ws;
    int lo = 0, hi = NPHASE;
    void* args[] = {&p, &lo, &hi};
    hipError_t e = hipLaunchCooperativeKernel((const void*)fwd_kernel, dim3(grid), dim3(512), args, LDS_BYTES, stream);
    if (e != hipSuccess) fprintf(stderr, "kernel_launch: cooperative launch failed: %s (grid %d)\n", hipGetErrorString(e), grid);
}
```

```cpp
#include <hip/hip_runtime.h>
#include <hip/hip_cooperative_groups.h>
#include <cstdio>
namespace cg = cooperative_groups;
__device__ __forceinline__ int tid_l() { int t = threadIdx.x; asm volatile("" : "+v"(t)); return t; }
__device__ __forceinline__ int bid_l() { int t = blockIdx.x; asm volatile("" : "+s"(t)); return t; }
namespace pg8 {
#define PG8_LAS __attribute__((address_space(3)))
typedef unsigned short bf16_t;
typedef short bf16x8 __attribute__((ext_vector_type(8)));
typedef float f32x4 __attribute__((ext_vector_type(4)));
typedef unsigned u32x4 __attribute__((ext_vector_type(4)));
constexpr int BM = 256, BK = 64, HALF = 128, HTB = HALF * BK * 2  , STAGE_BYTES = 8 * HTB, NXCD = 8, WGM = 8;

__host__ __device__ __forceinline__ int lds_byte(int r, int c) { const int st = (r >> 4) * 2 + (c >> 5), rr = r & 15, cc = c & 31, ob = rr * 64 + cc * 2; return st * 1024 + (ob ^ (((ob >> 9) & 1) << 5)); }
__host__ __device__ __forceinline__ void stage_rc(int b, int& R, int& C) { const int st = b / 1024, sb = b % 1024, swz = sb ^ (((sb >> 9) & 1) << 5); R = (st >> 1) * 16 + swz / 64; C = (st & 1) * 32 + (swz % 64) / 2; }
__host__ __device__ __forceinline__ int perm32(int rho) { const int n = rho >> 4, i = rho & 15; return 8 * (i >> 2) + 4 * n + (i & 3); }

struct Unit { int pm, pn; };
struct Gemm { const bf16_t* A; const bf16_t* Bt; int M, N, K; };

struct StaticOrder {
    int nM, nN, nwg, G, c;
    __host__ __device__ void init(int M, int N, int G_, int c_) { nM = M / BM; nN = N / BM; nwg = nM * nN; G = G_; c = c_; }
    __host__ __device__ bool next(int i, Unit& u) const {
        const long L = (long)i * G + c; if (L >= nwg) return false;
        int wgid = (int)L; { const int q = nwg / NXCD, r = nwg % NXCD, xcd = wgid % NXCD, off = wgid / NXCD; wgid = (xcd < r ? xcd * (q + 1) : r * (q + 1) + (xcd - r) * q) + off; }
        const int nig = WGM * nN, gid = wgid / nig, fm = gid * WGM, gsz = (nM - fm) < WGM ? (nM - fm) : WGM;
        u.pm = fm + ((wgid % nig) % gsz); u.pn = (wgid % nig) / gsz; return true;
    }
    __device__ __forceinline__ void a_ready(const Unit&) const {}
    __device__ __forceinline__ void done(const Unit&) const {}
};
__device__ __forceinline__ unsigned cvt_pk_bf16(float lo, float hi) { unsigned r; asm volatile("v_cvt_pk_bf16_f32 %0, %1, %2" : "=v"(r) : "v"(lo), "v"(hi)); return r; }
template <class Epi, class Sched, bool STAMP = false>
__device__ __forceinline__ void gemm_phase(PG8_LAS unsigned char* lds, const Gemm g, const Sched& S, const Epi& E, unsigned long long* stamps) {
    const int tid = tid_l(), wid = __builtin_amdgcn_readfirstlane(tid >> 6), lane = tid & 63, wr = wid >> 2, wc = wid & 3, fr = lane & 15, fq = lane >> 4;
    const int K = g.K, nt = K / BK;
    int ts_lo = 0, ts_hi = 0, nts = 0; const unsigned long long rt_entry = STAMP ? (unsigned long long)wall_clock64() : 0ull;
#define PG8_STAMP() do { if (STAMP && wid == 0 && nts < 64) { const unsigned long long _c = (unsigned long long)clock64(); \
        ts_lo = (lane == nts) ? (int)(unsigned)_c : ts_lo; ts_hi = (lane == nts) ? (int)(unsigned)(_c >> 32) : ts_hi; ++nts; } } while (0)
    PG8_STAMP();
    unsigned voffA[2], voffB[2];
#pragma unroll
    for (int i = 0; i < 2; ++i) { int R, C; stage_rc(tid * 16 + i * 8192, R, C); const int Rb = Epi::PERM ? ((R & ~31) + perm32(R & 31)) : R;
        voffA[i] = (unsigned)(R * K + C) * 2u; voffB[i] = (unsigned)(Rb * K + C) * 2u; }
    const size_t kstep = (size_t)(BK * 2);
    const size_t hstep = (size_t)HALF * K * 2;
    const size_t tstep = 2 * hstep;
    const unsigned ldsw = (unsigned)wid * 1024u;
    const int aoff = lds_byte(wr * 64 + fr, fq * 8), boff = lds_byte(wc * 32 + fr, fq * 8);
#define PG8_SA(b, h) (((b) * 2 + (h)) * HTB)
#define PG8_SB(b, h) ((4 + (b) * 2 + (h)) * HTB)
#define PG8_STAGE(bufoff, gbase, voff) do { _Pragma("unroll") for (int _i = 0; _i < 2; ++_i) \
        __builtin_amdgcn_global_load_lds((const unsigned*)((const char*)(gbase) + (voff)[_i]), (PG8_LAS unsigned*)(lds + (bufoff) + ldsw + _i * 8192), 16, 0, 0); } while (0)
#define PG8_LDA(dst, b, h) do { _Pragma("unroll") for (int m = 0; m < 4; ++m) _Pragma("unroll") for (int k = 0; k < 2; ++k) dst[m][k] = *(const PG8_LAS bf16x8*)(lds + PG8_SA(b, h) + aoff + m * 2048 + k * 1024); } while (0)
#define PG8_LDB(dst, b, h) do { _Pragma("unroll") for (int n = 0; n < 2; ++n) _Pragma("unroll") for (int k = 0; k < 2; ++k) dst[n][k] = *(const PG8_LAS bf16x8*)(lds + PG8_SB(b, h) + boff + n * 2048 + k * 1024); } while (0)
#define PG8_MMA(ai, bj, At, Bt) do { __builtin_amdgcn_s_setprio(1); _Pragma("unroll") for (int m = 0; m < 4; ++m) _Pragma("unroll") for (int n = 0; n < 2; ++n) _Pragma("unroll") for (int k = 0; k < 2; ++k) \
        acc[ai][bj][m][n] = __builtin_amdgcn_mfma_f32_16x16x32_bf16(Bt[n][k], At[m][k], acc[ai][bj][m][n], 0, 0, 0); __builtin_amdgcn_s_setprio(0); } while (0)
#define PG8_WAIT_V(n) asm volatile("s_waitcnt vmcnt(" #n ")" ::: "memory")
#define PG8_WAIT_L(n) asm volatile("s_waitcnt lgkmcnt(" #n ")" ::: "memory")
#define PG8_BAR __builtin_amdgcn_s_barrier()
#define PG8_SCHED __builtin_amdgcn_sched_barrier(0)
    Unit cur, nxt; int ui = 0;
    if (!S.next(0, cur)) return;
    f32x4 acc[2][2][4][2];
#pragma unroll
    for (int a = 0; a < 2; ++a)
#pragma unroll
        for (int b = 0; b < 2; ++b)
#pragma unroll
            for (int m = 0; m < 4; ++m)
#pragma unroll
                for (int n = 0; n < 2; ++n) acc[a][b][m][n] = (f32x4){0.f, 0.f, 0.f, 0.f};
    bf16x8 At[4][2], B0[2][2], B1[2][2];
    const char* cA = (const char*)g.A + (size_t)cur.pm * tstep; const char* cB = (const char*)g.Bt + (size_t)cur.pn * tstep;
    S.a_ready(cur);
    PG8_STAGE(PG8_SB(0, 0), cB, voffB); PG8_STAGE(PG8_SA(0, 0), cA, voffA); PG8_STAGE(PG8_SB(0, 1), cB + hstep, voffB); PG8_STAGE(PG8_SA(0, 1), cA + hstep, voffA);
    if (wr == 1) PG8_BAR;
    PG8_WAIT_V(4); PG8_BAR;
    PG8_STAGE(PG8_SB(1, 0), cB + kstep, voffB); PG8_STAGE(PG8_SA(1, 0), cA + kstep, voffA); PG8_STAGE(PG8_SB(1, 1), cB + hstep + kstep, voffB);
    PG8_WAIT_V(6); PG8_BAR;
    PG8_STAMP();
    for (;;) {
        const bool has_next = S.next(ui + 1, nxt);
        const char* nA = has_next ? (const char*)g.A + (size_t)nxt.pm * tstep : cA; const char* nB = has_next ? (const char*)g.Bt + (size_t)nxt.pn * tstep : cB;
        for (int t = 0; t < nt; t += 2) {
            const bool last = (t == nt - 2);
            const char* a1 = cA + (size_t)(t + 1) * kstep;
            const char* a2 = last ? nA : cA + (size_t)(t + 2) * kstep; const char* b2 = last ? nB : cB + (size_t)(t + 2) * kstep;
            const char* a3 = a2 + kstep; const char* b3 = b2 + kstep;
            if (last && has_next) S.a_ready(nxt);
            PG8_LDB(B0, 0, 0); PG8_SCHED; PG8_LDA(At, 0, 0); PG8_STAGE(PG8_SA(1, 1), a1 + hstep, voffA);
            PG8_WAIT_L(8); PG8_BAR; PG8_WAIT_L(0); PG8_MMA(0, 0, At, B0); PG8_BAR; PG8_SCHED;
            PG8_LDB(B1, 0, 1); PG8_STAGE(PG8_SB(0, 0), b2, voffB);
            PG8_BAR; PG8_WAIT_L(0); PG8_MMA(0, 1, At, B1); PG8_BAR;
            PG8_LDA(At, 0, 1); PG8_STAGE(PG8_SA(0, 0), a2, voffA);
            PG8_BAR; PG8_WAIT_L(0); PG8_MMA(1, 0, At, B0); PG8_BAR; PG8_SCHED;
            PG8_STAGE(PG8_SB(0, 1), b2 + hstep, voffB);
            PG8_WAIT_V(6); PG8_BAR; PG8_MMA(1, 1, At, B1); PG8_BAR;
            PG8_LDB(B0, 1, 0); PG8_SCHED; PG8_LDA(At, 1, 0); PG8_STAGE(PG8_SA(0, 1), a2 + hstep, voffA);
            PG8_WAIT_L(8); PG8_BAR; PG8_WAIT_L(0); PG8_MMA(0, 0, At, B0); PG8_BAR; PG8_SCHED;
            PG8_LDB(B1, 1, 1); PG8_STAGE(PG8_SB(1, 0), b3, voffB);
            PG8_BAR; PG8_WAIT_L(0); PG8_MMA(0, 1, At, B1); PG8_BAR;
            PG8_LDA(At, 1, 1); PG8_STAGE(PG8_SA(1, 0), a3, voffA);
            PG8_BAR; PG8_WAIT_L(0); PG8_MMA(1, 0, At, B0); PG8_BAR; PG8_SCHED;
            PG8_STAGE(PG8_SB(1, 1), b3 + hstep, voffB);
            PG8_WAIT_V(6); PG8_BAR; PG8_MMA(1, 1, At, B1); PG8_BAR;
        }
        PG8_STAMP();
        if constexpr (!Epi::AFTER_DRAIN) { E(acc, cur, wr, wc, fr, fq); S.done(cur); }
        PG8_STAMP();
        if (!has_next) break;
#pragma unroll
        for (int a = 0; a < 2; ++a)
#pragma unroll
            for (int b = 0; b < 2; ++b)
#pragma unroll
                for (int m = 0; m < 4; ++m)
#pragma unroll
                    for (int n = 0; n < 2; ++n) acc[a][b][m][n] = (f32x4){0.f, 0.f, 0.f, 0.f};
        cur = nxt; cA = nA; cB = nB; ++ui;
    }
    PG8_WAIT_V(0);
    if (wr == 0) PG8_BAR;
    PG8_BAR;
    if constexpr (Epi::AFTER_DRAIN) { E.fused(acc, cur, wr, wc, fr, fq, lds, wid, lane); S.done(cur); }
    PG8_STAMP();
    if (STAMP && wid == 0) { stamps[lane] = lane < nts ? (((unsigned long long)(unsigned)ts_hi << 32) | (unsigned)ts_lo) : 0ull;
        if (lane == 62) stamps[62] = rt_entry; if (lane == 63) stamps[63] = (unsigned long long)wall_clock64(); }
#undef PG8_STAMP
#undef PG8_SA
#undef PG8_SB
#undef PG8_STAGE
#undef PG8_LDA
#undef PG8_LDB
#undef PG8_MMA
#undef PG8_WAIT_V
#undef PG8_WAIT_L
#undef PG8_BAR
#undef PG8_SCHED
}
}

using pg8::bf16_t; using pg8::bf16x8; using pg8::f32x4; using pg8::u32x4; using pg8::cvt_pk_bf16; using pg8::Unit;
#define LAS __attribute__((address_space(3)))
typedef unsigned u32x2 __attribute__((ext_vector_type(2)));

constexpr int D = 1024, NBATCH = 16, SEQ = 2048, CTXL = 256, DEPTH = 4, DIN = 3344, NP = 3328, DFF = 2816;
constexpr int RLAT = NBATCH * SEQ, RCTX = NBATCH * CTXL, ROWS = RLAT + RCTX;
constexpr int PK = 0, PV = 512, PQ = 1024, PO = 1536, PCB = 2048, PCC = 2304, PCH = 2560, PGU = 2816, PGV = 3072;
constexpr float EPS = 1e-6f;
constexpr int LDS_BYTES = 147456;
#ifndef PROBE
#define PROBE 0
#endif
constexpr int NPHASE = 2 + 8 * DEPTH;
constexpr size_t WS_CTXW = 0;
constexpr size_t WS_ACT = WS_CTXW + (size_t)RCTX * D * 4;
constexpr size_t WS_PBUF = WS_ACT + (size_t)ROWS * D * 2;
constexpr size_t WS_HB = WS_PBUF + (size_t)ROWS * NP * 2;
constexpr size_t WS_GATES = WS_HB + (size_t)ROWS * 512 * 2;
constexpr size_t WS_MOD = WS_GATES + (size_t)ROWS * 16 * 4;
constexpr size_t WS_WB = WS_MOD + (size_t)DEPTH * 17 * 6144 * 4;
constexpr size_t WL_IN = 0, WL_OUT = (size_t)NP * D, WL_13 = WL_OUT + (size_t)D * D, WL_2 = WL_13 + (size_t)2 * DFF * D, WL_SZ = WL_2 + (size_t)D * DFF;
constexpr size_t WS_BAR = WS_WB + (size_t)DEPTH * WL_SZ * 2;
constexpr size_t WS_END = WS_BAR + 16384;

struct Params { const float* in[20]; float* out; unsigned char* ws; };

__device__ __forceinline__ float bflo(unsigned u) { return __uint_as_float(u << 16); }
__device__ __forceinline__ float bfhi(unsigned u) { return __uint_as_float(u & 0xffff0000u); }
__device__ __forceinline__ float bf2f(short v) { return __uint_as_float(((unsigned)(unsigned short)v) << 16); }
__device__ __forceinline__ f32x4 mfma16(bf16x8 a, bf16x8 b, f32x4 c) { return __builtin_amdgcn_mfma_f32_16x16x32_bf16(a, b, c, 0, 0, 0); }
__device__ __forceinline__ float silu_f(float a) { return a * __builtin_amdgcn_rcpf(1.f + __expf(-a)); }

struct EpiP {
    static constexpr bool PERM = true, AFTER_DRAIN = false;
    bf16_t* O; int ldc;
    __device__ __forceinline__ void operator()(const f32x4 (&acc)[2][2][4][2], const Unit& u, int wr, int wc, int fr, int fq) const {
        const int row0 = u.pm * 256 + wr * 64 + fr, col0 = u.pn * 256 + wc * 32 + 8 * fq;
#pragma unroll
        for (int ai = 0; ai < 2; ++ai)
#pragma unroll
            for (int m = 0; m < 4; ++m) { bf16_t* rowp = O + (size_t)(row0 + ai * 128 + m * 16) * ldc + col0;
#pragma unroll
                for (int bj = 0; bj < 2; ++bj) { const f32x4 v0 = acc[ai][bj][m][0], v1 = acc[ai][bj][m][1];
                    u32x4 w; w.x = cvt_pk_bf16(v0[0], v0[1]); w.y = cvt_pk_bf16(v0[2], v0[3]); w.z = cvt_pk_bf16(v1[0], v1[1]); w.w = cvt_pk_bf16(v1[2], v1[3]);
                    *(u32x4*)(rowp + bj * 128) = w; } }
    }
};
struct EpiSwiglu {
    static constexpr bool PERM = true, AFTER_DRAIN = false;
    bf16_t* O;
    __device__ __forceinline__ void operator()(const f32x4 (&acc)[2][2][4][2], const Unit& u, int wr, int wc, int fr, int fq) const {
        const int row0 = u.pm * 256 + wr * 64 + fr, col0 = u.pn * 128 + wc * 32 + 8 * fq;
#pragma unroll
        for (int ai = 0; ai < 2; ++ai)
#pragma unroll
            for (int m = 0; m < 4; ++m) { bf16_t* rowp = O + (size_t)(row0 + ai * 128 + m * 16) * DFF + col0;
                const f32x4 a0 = acc[ai][0][m][0], a1 = acc[ai][0][m][1], b0 = acc[ai][1][m][0], b1 = acc[ai][1][m][1];
                u32x4 w;
                w.x = cvt_pk_bf16(silu_f(a0[0]) * b0[0], silu_f(a0[1]) * b0[1]); w.y = cvt_pk_bf16(silu_f(a0[2]) * b0[2], silu_f(a0[3]) * b0[3]);
                w.z = cvt_pk_bf16(silu_f(a1[0]) * b1[0], silu_f(a1[1]) * b1[1]); w.w = cvt_pk_bf16(silu_f(a1[2]) * b1[2], silu_f(a1[3]) * b1[3]);
                *(u32x4*)rowp = w; }
    }
};
struct EpiResid {
    static constexpr bool PERM = false, AFTER_DRAIN = false;
    float* xl; float* xc; const float* modl; int goff;
    __device__ __forceinline__ void operator()(const f32x4 (&acc)[2][2][4][2], const Unit& u, int wr, int wc, int fr, int fq) const {
        const int row0 = u.pm * 256 + wr * 64 + fr, col0 = u.pn * 256 + wc * 32 + 4 * fq;
        float* X = u.pm < 128 ? xl + (size_t)row0 * D : xc + (size_t)(row0 - RLAT) * D;
        const float* gp = modl + (size_t)(u.pm < 128 ? (u.pm >> 3) : 16) * 6144 + goff + col0;
        f32x4 gv[2][2];
#pragma unroll
        for (int bj = 0; bj < 2; ++bj)
#pragma unroll
            for (int n = 0; n < 2; ++n) gv[bj][n] = *(const f32x4*)(gp + bj * 128 + n * 16);
#pragma unroll
        for (int ai = 0; ai < 2; ++ai)
#pragma unroll
            for (int m = 0; m < 4; ++m) { float* rowp = X + (size_t)(ai * 128 + m * 16) * D + col0;
#pragma unroll
                for (int bj = 0; bj < 2; ++bj)
#pragma unroll
                    for (int n = 0; n < 2; ++n) { f32x4 xv = *(f32x4*)(rowp + bj * 128 + n * 16); xv += gv[bj][n] * acc[ai][bj][m][n]; *(f32x4*)(rowp + bj * 128 + n * 16) = xv; } }
    }
};

__device__ void phase_prep(const Params& p, LAS unsigned char* lds) {
    const int tid = tid_l(), w = tid >> 6, lane = tid & 63;
    float* MOD = (float*)(p.ws + WS_MOD);
    {
        LAS float* S = (LAS float*)lds;
        LAS float* R = S + 17 * 1024;
        for (int i = tid; i < 17 * 1024; i += 512) { const int r = i >> 10, k = i & 1023; const float v = r < 16 ? p.in[1][r * 1024 + k] : p.in[3][k]; S[i] = v / (1.f + expf(-v)); }
        __syncthreads();
        for (int item = bid_l(); item < 384; item += gridDim.x) {
            const int l = item / 96, n0 = (item % 96) * 64;
            const float* wa = p.in[4] + (size_t)l * 1024 * 6144 + n0 + lane;
            float acc[17];
#pragma unroll
            for (int r = 0; r < 17; ++r) acc[r] = 0.f;
            for (int k4 = 0; k4 < 32; ++k4) {
                const int k = w * 128 + k4 * 4;
                const float w0 = wa[(size_t)k * 6144], w1 = wa[(size_t)(k + 1) * 6144], w2 = wa[(size_t)(k + 2) * 6144], w3 = wa[(size_t)(k + 3) * 6144];
#pragma unroll
                for (int r = 0; r < 17; ++r) { const f32x4 s = *(const LAS f32x4*)(S + r * 1024 + k); acc[r] += s[0] * w0 + s[1] * w1 + s[2] * w2 + s[3] * w3; }
            }
#pragma unroll
            for (int r = 0; r < 17; ++r) R[(w * 17 + r) * 64 + lane] = acc[r];
            __syncthreads();
            for (int o = tid; o < 17 * 64; o += 512) { const int r = o >> 6, n = o & 63; float s = 0.f;
#pragma unroll
                for (int ww = 0; ww < 8; ++ww) s += R[(ww * 17 + r) * 64 + n];
                MOD[((size_t)l * 17 + r) * 6144 + n0 + n] = s + p.in[5][l * 6144 + n0 + n]; }
            __syncthreads();
        }
    }
    {
        LAS float* T = (LAS float*)lds;
        for (int item = bid_l(); item < DEPTH * 3200; item += gridDim.x) {
            const int l = item / 3200; int j = item % 3200;
            bf16_t* WB = (bf16_t*)(p.ws + WS_WB) + (size_t)l * WL_SZ;
            const float* src; int ld, col0, k0, K; bf16_t* dst; float scale = 1.f;
            if (j < 832) { const int n0 = (j >> 4) * 64; k0 = (j & 15) * 64; src = p.in[8] + (size_t)l * D * DIN; ld = DIN; col0 = n0 < 1024 ? n0 : n0 + 16; K = D; dst = WB + WL_IN + (size_t)n0 * D; if (n0 < 512) scale = 0.08838834764831845f; }
            else if (j < 1088) { j -= 832; const int n0 = (j >> 4) * 64; k0 = (j & 15) * 64; src = p.in[15] + (size_t)l * D * D; ld = D; col0 = n0; K = D; dst = WB + WL_OUT + (size_t)n0 * D; }
            else if (j < 2496) { j -= 1088; const int n0 = (j >> 4) * 64; k0 = (j & 15) * 64; const int pn = n0 >> 8, bj = (n0 >> 7) & 1, r0 = n0 & 127;
                src = (bj ? p.in[17] : p.in[16]) + (size_t)l * D * DFF; ld = DFF; col0 = pn * 128 + r0; K = D; dst = WB + WL_13 + (size_t)n0 * D; }
            else { j -= 2496; const int n0 = (j / 44) * 64; k0 = (j % 44) * 64; src = p.in[18] + (size_t)l * DFF * D; ld = D; col0 = n0; K = DFF; dst = WB + WL_2 + (size_t)n0 * DFF; }
#pragma unroll
            for (int hh = 0; hh < 2; ++hh) { const int k = (tid >> 4) + 32 * hh, n4 = (tid & 15) * 4;
                const f32x4 v = *(const f32x4*)(src + (size_t)(k0 + k) * ld + col0 + n4);
                T[k * 65 + n4] = v[0] * scale; T[k * 65 + n4 + 1] = v[1] * scale; T[k * 65 + n4 + 2] = v[2] * scale; T[k * 65 + n4 + 3] = v[3] * scale; }
            __syncthreads();
            { const int n = tid >> 3, k8 = (tid & 7) * 8; u32x4 o;
                o.x = cvt_pk_bf16(T[(k8 + 0) * 65 + n], T[(k8 + 1) * 65 + n]); o.y = cvt_pk_bf16(T[(k8 + 2) * 65 + n], T[(k8 + 3) * 65 + n]);
                o.z = cvt_pk_bf16(T[(k8 + 4) * 65 + n], T[(k8 + 5) * 65 + n]); o.w = cvt_pk_bf16(T[(k8 + 6) * 65 + n], T[(k8 + 7) * 65 + n]);
                *(u32x4*)(dst + (size_t)n * K + k0 + k8) = o; }
            __syncthreads();
        }
    }
    {
        const f32x4* xs = (const f32x4*)p.in[0]; f32x4* xd = (f32x4*)p.out;
        for (size_t i = (size_t)bid_l() * 512 + tid; i < (size_t)RLAT * D / 4; i += (size_t)gridDim.x * 512) xd[i] = xs[i];
        const f32x4* cs = (const f32x4*)p.in[2]; f32x4* cd = (f32x4*)(p.ws + WS_CTXW);
        for (size_t i = (size_t)bid_l() * 512 + tid; i < (size_t)RCTX * D / 4; i += (size_t)gridDim.x * 512) cd[i] = cs[i];
    }
}

__device__ __forceinline__ void gates_row(const f32x4 (&y)[4], const LAS float* Wgt, int lane, float* gout, const float* bg) {
    float gv[16];
#pragma unroll
    for (int n = 0; n < 16; ++n) { float f = 0.f;
#pragma unroll
        for (int j = 0; j < 4; ++j) { const f32x4 wv = *(const LAS f32x4*)(Wgt + n * 1024 + j * 256 + lane * 4); f += y[j][0] * wv[0] + y[j][1] * wv[1] + y[j][2] * wv[2] + y[j][3] * wv[3]; }
        gv[n] = f; }
    { const bool hi = lane & 32;
#pragma unroll
        for (int i = 0; i < 8; ++i) { const float send = hi ? gv[i] : gv[i + 8], keep = hi ? gv[i + 8] : gv[i]; gv[i] = keep + __shfl_xor(send, 32); } }
    { const bool hi = lane & 16;
#pragma unroll
        for (int i = 0; i < 4; ++i) { const float send = hi ? gv[i] : gv[i + 4], keep = hi ? gv[i + 4] : gv[i]; gv[i] = keep + __shfl_xor(send, 16); } }
    { const bool hi = lane & 8;
#pragma unroll
        for (int i = 0; i < 2; ++i) { const float send = hi ? gv[i] : gv[i + 2], keep = hi ? gv[i + 2] : gv[i]; gv[i] = keep + __shfl_xor(send, 8); } }
    { const bool hi = lane & 4; const float send = hi ? gv[0] : gv[1], keep = hi ? gv[1] : gv[0]; gv[0] = keep + __shfl_xor(send, 4); }
    gv[0] += __shfl_xor(gv[0], 2); gv[0] += __shfl_xor(gv[0], 1);
    const int n = (lane >> 2) & 15;
    if ((lane & 3) == 0) gout[n] = gv[0] + bg[n];
}
template <int MODE> __device__ void phase_norm(const Params& p, int l, int nrows, LAS unsigned char* lds) {
    const int tid = tid_l(), w = tid >> 6, lane = tid & 63;
    LAS float* Wgt = (LAS float*)lds;
    if (MODE == 0) { const float* wi = p.in[8] + (size_t)l * D * DIN + 1024;
        for (int i = tid; i < 16384; i += 512) { const int k = i >> 4, n = i & 15; Wgt[n * 1024 + k] = wi[(size_t)k * DIN + n]; }
        __syncthreads(); }
    const float* nw = MODE == 0 ? p.in[6] + l * D : (MODE == 1 ? p.in[7] + l * D : p.in[19]);
    const float* MOD = (const float*)(p.ws + WS_MOD) + (size_t)l * 17 * 6144;
    bf16_t* ACT = (bf16_t*)(p.ws + WS_ACT); float* GATES = (float*)(p.ws + WS_GATES); float* CTXW = (float*)(p.ws + WS_CTXW);
    f32x4 nv[4];
#pragma unroll
    for (int j = 0; j < 4; ++j) nv[j] = *(const f32x4*)(nw + j * 256 + lane * 4);
    const int rstride = gridDim.x * 8;
    for (int rowa = bid_l() * 8 + w; rowa < nrows; rowa += 2 * rstride) {
        float* xr[2]; f32x4 xv[2][4]; float rstd[2];
#pragma unroll
        for (int q = 0; q < 2; ++q) { const int row = rowa + q * rstride; xr[q] = row < RLAT ? p.out + (size_t)row * D : CTXW + (size_t)(row - RLAT) * D;
#pragma unroll
            for (int j = 0; j < 4; ++j) xv[q][j] = *(const f32x4*)(xr[q] + j * 256 + lane * 4); }
#pragma unroll
        for (int q = 0; q < 2; ++q) { float ss = 0.f;
#pragma unroll
            for (int j = 0; j < 4; ++j) ss += xv[q][j][0] * xv[q][j][0] + xv[q][j][1] * xv[q][j][1] + xv[q][j][2] * xv[q][j][2] + xv[q][j][3] * xv[q][j][3];
#pragma unroll
            for (int o = 32; o >= 1; o >>= 1) ss += __shfl_xor(ss, o);
            rstd[q] = rsqrtf(ss * (1.f / 1024.f) + EPS); }
        if (MODE == 2) {
#pragma unroll
            for (int q = 0; q < 2; ++q)
#pragma unroll
                for (int j = 0; j < 4; ++j) *(f32x4*)(xr[q] + j * 256 + lane * 4) = xv[q][j] * rstd[q] * nv[j];
            continue;
        }
        f32x4 y[2][4];
#pragma unroll
        for (int q = 0; q < 2; ++q) { const int row = rowa + q * rstride;
            const float* mr = MOD + (size_t)(row < RLAT ? (row >> 11) : 16) * 6144 + (MODE == 0 ? 0 : 3072);
#pragma unroll
            for (int j = 0; j < 4; ++j) { const f32x4 sh = *(const f32x4*)(mr + j * 256 + lane * 4), scl = *(const f32x4*)(mr + 1024 + j * 256 + lane * 4);
                y[q][j] = xv[q][j] * rstd[q] * nv[j] * (scl + 1.f) + sh;
                u32x2 o; o.x = cvt_pk_bf16(y[q][j][0], y[q][j][1]); o.y = cvt_pk_bf16(y[q][j][2], y[q][j][3]);
                *(u32x2*)(ACT + (size_t)row * D + j * 256 + lane * 4) = o; } }
        if (MODE == 0) {
            gates_row(y[0], Wgt, lane, GATES + (size_t)rowa * 16, p.in[9] + l * 16);
            __builtin_amdgcn_sched_barrier(0);
            gates_row(y[1], Wgt, lane, GATES + (size_t)(rowa + rstride) * 16, p.in[9] + l * 16);
        }
    }
}

typedef short s16x4 __attribute__((ext_vector_type(4)));
__device__ __forceinline__ unsigned offb(unsigned row, unsigned ch) { return 256u * row + 16u * (ch ^ (((row & 3u) << 2) | ((row >> 2) & 3u))); }
__device__ __forceinline__ bf16x8 rd_row(const LAS unsigned char* img, unsigned row, unsigned ch) { return *(const LAS bf16x8*)(img + offb(row, ch)); }
__device__ __forceinline__ bf16x8 rd_tr(const LAS unsigned char* img, unsigned lane, unsigned c, unsigned ks) {
    const unsigned g = lane >> 4, q = (lane & 15u) >> 2, pp = lane & 3u;
    const unsigned r0 = 32u * ks + 8u * g + q;
    const s16x4 a = __builtin_amdgcn_ds_read_tr16_b64_v4i16((LAS s16x4*)(img + offb(r0, 2u * c + (pp >> 1)) + 8u * (pp & 1u)));
    const s16x4 b = __builtin_amdgcn_ds_read_tr16_b64_v4i16((LAS s16x4*)(img + offb(r0 + 4u, 2u * c + (pp >> 1)) + 8u * (pp & 1u)));
    return __builtin_shufflevector(a, b, 0, 1, 2, 3, 4, 5, 6, 7);
}
__device__ void chain_item(const Params& p, int item, bool last, LAS unsigned char* lds) {
    const int tid = tid_l(), w = __builtin_amdgcn_readfirstlane(tid >> 6), lane = tid & 63, fr = lane & 15, fq = lane >> 4;
    const int vh = item & 1, dir = (item >> 1) & 1, h = (item >> 2) & 3, b = item >> 4;
    LAS unsigned char* Qs = lds;
    LAS unsigned char* Kw = lds + 32768;
    LAS unsigned char* Vs = lds + 65536;
    LAS unsigned char* Ct = lds + 98304;
    LAS float* s_a = (LAS float*)(lds + 114688);
    LAS float* s_cm = s_a + 18 * 128;
    LAS float* s_b = s_cm + 18 * 128;
    LAS float* s_nv = s_b + 18 * 128;
    const bf16_t* PB = (const bf16_t*)(p.ws + WS_PBUF); const float* GATES = (const float*)(p.ws + WS_GATES);
    bf16_t* ACT = (bf16_t*)(p.ws + WS_ACT); bf16_t* HB = (bf16_t*)(p.ws + WS_HB);
#define CHUNK_BASE(s) (dir == 0 ? ((s) < 2 ? RLAT + b * CTXL + 128 * (s) : b * SEQ + 128 * ((s) - 2)) : ((s) < 2 ? RLAT + b * CTXL + 128 * (1 - (s)) : b * SEQ + 128 * (17 - (s))))
#define LOAD_CHUNK(s) do { const int _base = CHUNK_BASE(s); \
        _Pragma("unroll") for (int e = 0; e < 4; ++e) { const int _row = e * 32 + (tid >> 4); const int _tok = _base + (dir ? 127 - _row : _row); \
            const bf16_t* _pr = PB + (size_t)_tok * NP + 128 * h + (tid & 15) * 8; qreg[e] = *(const u32x4*)(_pr + PQ); kreg[e] = *(const u32x4*)(_pr + PK); vreg[e] = *(const u32x4*)(_pr + PV); } } while (0)
    u32x4 qreg[4], kreg[4], vreg[4];
    LOAD_CHUNK(0);
    for (int j = w; j < 18; j += 8) {
        const int cb = CHUNK_BASE(j);
        const int t0 = cb + (dir ? 127 - 2 * lane : 2 * lane), t1 = cb + (dir ? 126 - 2 * lane : 2 * lane + 1);
        const float* g0 = GATES + (size_t)t0 * 16 + dir * 8 + h; const float* g1 = GATES + (size_t)t1 * 16 + dir * 8 + h;
        const float i0 = g0[0], f0 = g0[4], i1 = g1[0], f1 = g1[4];
        const float l0 = fminf(f0, 0.f) - log1pf(expf(-fabsf(f0))), l1 = fminf(f1, 0.f) - log1pf(expf(-fabsf(f1)));
        float incl = l0 + l1;
#pragma unroll
        for (int off = 1; off < 64; off <<= 1) { const float tv = __shfl_up(incl, off); if (lane >= off) incl += tv; }
        const float b1 = incl, b0 = incl - l1;
        const float a0 = i0 - b0, a1 = i1 - b1;
        float mx = fmaxf(a0, a1);
#pragma unroll
        for (int off = 1; off < 64; off <<= 1) { const float tv = __shfl_up(mx, off); if (lane >= off) mx = fmaxf(mx, tv); }
        float ex = __shfl_up(mx, 1); if (lane == 0) ex = -INFINITY;
        s_a[j * 128 + 2 * lane] = a0; s_a[j * 128 + 2 * lane + 1] = a1;
        s_cm[j * 128 + 2 * lane] = fmaxf(ex, a0); s_cm[j * 128 + 2 * lane + 1] = mx;
        s_b[j * 128 + 2 * lane] = b0; s_b[j * 128 + 2 * lane + 1] = b1;
    }
    for (int i = tid; i < 16384 / 4; i += 512) ((LAS unsigned*)Ct)[i] = 0u;
    if (tid < 128) s_nv[tid] = 0.f;
    f32x4 cacc[4], nacc = (f32x4){0.f, 0.f, 0.f, 0.f};
#pragma unroll
    for (int x = 0; x < 4; ++x) cacc[x] = (f32x4){0.f, 0.f, 0.f, 0.f};
    float m_st = 0.f;
    bf16x8 ones;
#pragma unroll
    for (int x = 0; x < 8; ++x) ones[x] = (short)0x3F80;
    __syncthreads();
    const int t = 16 * w + fr;
    const int jt_s = w & 3, it0 = (w >> 2) * 4;
    for (int s = 0; s < 18; ++s) {
        const int base = CHUNK_BASE(s);
        const float c127 = fmaxf(m_st, s_cm[s * 128 + 127]), b127 = s_b[s * 128 + 127];
        const float decay = expf(m_st - c127);
#pragma unroll
        for (int e = 0; e < 4; ++e) { const int row = e * 32 + (tid >> 4), ch = tid & 15; const float wv = expf(s_a[s * 128 + row] - c127); u32x4 o;
#pragma unroll
            for (int x = 0; x < 4; ++x) { const unsigned u = kreg[e][x]; o[x] = cvt_pk_bf16(bflo(u) * wv, bfhi(u) * wv); }
            const unsigned ob = offb(row, ch);
            *(LAS u32x4*)(Qs + ob) = qreg[e]; *(LAS u32x4*)(Kw + ob) = o; *(LAS u32x4*)(Vs + ob) = vreg[e]; }
        if (s + 1 < 18) LOAD_CHUNK(s + 1);
        __syncthreads();
        bf16x8 qa[4];
#pragma unroll
        for (int kk = 0; kk < 4; ++kk) qa[kk] = rd_row(Qs, t, 4 * kk + fq);
        float qn = 0.f;
#pragma unroll
        for (int kk = 0; kk < 4; ++kk) { const f32x4 n0 = *(const LAS f32x4*)(s_nv + 32 * kk + 8 * fq), n1 = *(const LAS f32x4*)(s_nv + 32 * kk + 8 * fq + 4);
            qn += bf2f(qa[kk][0]) * n0[0] + bf2f(qa[kk][1]) * n0[1] + bf2f(qa[kk][2]) * n0[2] + bf2f(qa[kk][3]) * n0[3]
                + bf2f(qa[kk][4]) * n1[0] + bf2f(qa[kk][5]) * n1[1] + bf2f(qa[kk][6]) * n1[2] + bf2f(qa[kk][7]) * n1[3]; }
        qn += __shfl_xor(qn, 16); qn += __shfl_xor(qn, 32);
        float rs = 0.f;
#pragma unroll
        for (int n = 0; n < 8; ++n) { if (n > (w | 1)) continue;
            f32x4 sa = (f32x4){0.f, 0.f, 0.f, 0.f};
#pragma unroll
            for (int kk = 0; kk < 4; ++kk) sa = mfma16(rd_row(Kw, 16 * n + fr, 4 * kk + fq), qa[kk], sa);
#pragma unroll
            for (int r = 0; r < 4; ++r) { const int s_ = 16 * n + 4 * fq + r; sa[r] = (s_ <= t) ? sa[r] : 0.f; rs += sa[r]; }
            u32x2 pk; pk.x = cvt_pk_bf16(sa[0], sa[1]); pk.y = cvt_pk_bf16(sa[2], sa[3]);
            *(LAS u32x2*)(Qs + offb(t, 2 * n + (fq >> 1)) + 8 * (fq & 1)) = pk; }
        rs += __shfl_xor(rs, 16); rs += __shfl_xor(rs, 32);
        f32x4 u1[4], u2[4];
#pragma unroll
        for (int jt = 0; jt < 4; ++jt) { u2[jt] = (f32x4){0.f, 0.f, 0.f, 0.f};
#pragma unroll
            for (int kk = 0; kk < 4; ++kk) u2[jt] = mfma16(rd_row(Ct, 16 * jt + fr, 4 * kk + fq), qa[kk], u2[jt]); }
        { bf16x8 pb[4];
#pragma unroll
            for (int kk = 0; kk < 4; ++kk) pb[kk] = rd_row(Qs, t, 4 * kk + fq);
#pragma unroll
            for (int jt = 0; jt < 4; ++jt) u1[jt] = (f32x4){0.f, 0.f, 0.f, 0.f};
#pragma unroll
            for (int kk = 0; kk < 4; ++kk) { if (kk > (w >> 1)) continue;
#pragma unroll
                for (int jt = 0; jt < 4; ++jt) u1[jt] = mfma16(rd_tr(Vs, lane, 4 * vh + jt, kk), pb[kk], u1[jt]); } }
        if (!(last && s < 2)) {
            const float ct = fmaxf(m_st, s_cm[s * 128 + t]);
            const float gt = expf(c127 - ct), it = expf(m_st - ct), em = expf(-(s_b[s * 128 + t] + ct));
            const float den = gt * rs + it * qn; const float inv = 1.f / fmaxf(fabsf(den), em);
            const int tok = base + (dir ? 127 - t : t);
            bf16_t* dst = (dir == 0 ? ACT + (size_t)tok * D : HB + (size_t)tok * 512) + 128 * h + 64 * vh + 4 * fq;
#pragma unroll
            for (int jt = 0; jt < 4; ++jt) { u32x2 o; o.x = cvt_pk_bf16((gt * u1[jt][0] + it * u2[jt][0]) * inv, (gt * u1[jt][1] + it * u2[jt][1]) * inv);
                o.y = cvt_pk_bf16((gt * u1[jt][2] + it * u2[jt][2]) * inv, (gt * u1[jt][3] + it * u2[jt][3]) * inv);
                *(u32x2*)(dst + 16 * jt) = o; }
        }
#pragma unroll
        for (int x = 0; x < 4; ++x) cacc[x] *= decay;
        nacc *= decay;
#pragma unroll
        for (int kk = 0; kk < 4; ++kk) { const bf16x8 vb = rd_tr(Vs, lane, 4 * vh + jt_s, kk);
#pragma unroll
            for (int x = 0; x < 4; ++x) cacc[x] = mfma16(rd_tr(Kw, lane, it0 + x, kk), vb, cacc[x]);
            nacc = mfma16(rd_tr(Kw, lane, w, kk), ones, nacc); }
        m_st = b127 + c127;
        __syncthreads();
#pragma unroll
        for (int x = 0; x < 4; ++x) { u32x2 o; o.x = cvt_pk_bf16(cacc[x][0], cacc[x][1]); o.y = cvt_pk_bf16(cacc[x][2], cacc[x][3]);
            *(LAS u32x2*)(Ct + offb(16 * jt_s + fr, 2 * (it0 + x) + (fq >> 1)) + 8 * (fq & 1)) = o; }
        if (fr == 0) *(LAS f32x4*)(s_nv + 16 * w + 4 * fq) = nacc;
    }
    __syncthreads();
#undef LOAD_CHUNK
#undef CHUNK_BASE
}

__device__ void gmlp_item(const Params& p, int l, int ch, LAS unsigned char* lds) {
    const int tid = tid_l(), w = tid >> 6, lane = tid & 63, fr = lane & 15, fq = lane >> 4;
    const bf16_t* PB = (const bf16_t*)(p.ws + WS_PBUF); bf16_t* ACT = (bf16_t*)(p.ws + WS_ACT);
    const int row0 = ch * 128;
    { const int c8 = (tid & 31) * 8; const float* gn = p.in[12] + l * 256 + c8;
        const f32x4 g0 = *(const f32x4*)gn, g1 = *(const f32x4*)(gn + 4);
        u32x4 vv[8];
#pragma unroll
        for (int ps = 0; ps < 8; ++ps) vv[ps] = *(const u32x4*)(PB + (size_t)(row0 + ps * 16 + (tid >> 5)) * NP + PGV + c8);
#pragma unroll
        for (int ps = 0; ps < 8; ++ps) { const int s = ps * 16 + (tid >> 5);
            const u32x4 v = vv[ps];
            float f[8]; f[0] = bflo(v.x); f[1] = bfhi(v.x); f[2] = bflo(v.y); f[3] = bfhi(v.y); f[4] = bflo(v.z); f[5] = bfhi(v.z); f[6] = bflo(v.w); f[7] = bfhi(v.w);
            float ss = 0.f;
#pragma unroll
            for (int x = 0; x < 8; ++x) ss += f[x] * f[x];
#pragma unroll
            for (int o = 16; o >= 1; o >>= 1) ss += __shfl_xor(ss, o);
            const float rstd = rsqrtf(ss * (1.f / 256.f) + EPS);
            u32x4 o; o.x = cvt_pk_bf16(f[0] * rstd * g0[0], f[1] * rstd * g0[1]); o.y = cvt_pk_bf16(f[2] * rstd * g0[2], f[3] * rstd * g0[3]);
            o.z = cvt_pk_bf16(f[4] * rstd * g1[0], f[5] * rstd * g1[1]); o.w = cvt_pk_bf16(f[6] * rstd * g1[2], f[7] * rstd * g1[3]);
            *(LAS u32x4*)(lds + 32768 * ((tid & 31) >> 4) + offb(s, tid & 15)) = o; } }
    __syncthreads();
    const int t = 16 * w + fr;
    const size_t grow = (size_t)(row0 + t);
#pragma unroll 1
    for (int g = 0; g < 4; ++g) {
        const float* wsr = p.in[13] + (((size_t)l * 4 + g) * 128 + t) * 128;
        bf16x8 wb[4];
#pragma unroll
        for (int kk = 0; kk < 4; ++kk) { const f32x4 a = *(const f32x4*)(wsr + 32 * kk + 8 * fq), c = *(const f32x4*)(wsr + 32 * kk + 8 * fq + 4);
            u32x4 o; o.x = cvt_pk_bf16(a[0], a[1]); o.y = cvt_pk_bf16(a[2], a[3]); o.z = cvt_pk_bf16(c[0], c[1]); o.w = cvt_pk_bf16(c[2], c[3]);
            wb[kk] = __builtin_bit_cast(bf16x8, o); }
        const float bs = p.in[14][((size_t)l * 4 + g) * 128 + t];
        const LAS unsigned char* img = lds + 32768 * (g >> 1);
#pragma unroll
        for (int cc = 0; cc < 4; ++cc) { const int ct = 4 * g + cc; f32x4 acc = (f32x4){0.f, 0.f, 0.f, 0.f};
#pragma unroll
            for (int kk = 0; kk < 4; ++kk) acc = mfma16(rd_tr(img, lane, ct & 7, kk), wb[kk], acc);
            const int c = 16 * ct + 4 * fq;
            const u32x2 uu = *(const u32x2*)(PB + grow * NP + PGU + c);
            u32x2 o; o.x = cvt_pk_bf16(bflo(uu.x) * (acc[0] + bs), bfhi(uu.x) * (acc[1] + bs)); o.y = cvt_pk_bf16(bflo(uu.y) * (acc[2] + bs), bfhi(uu.y) * (acc[3] + bs));
            *(u32x2*)(ACT + grow * D + 768 + c) = o; }
    }
    __syncthreads();
}

__device__ void conv_all(const Params& p, int l, int nrows) {
    const bf16_t* PB = (const bf16_t*)(p.ws + WS_PBUF); bf16_t* ACT = (bf16_t*)(p.ws + WS_ACT);
    const float* cw = p.in[11] + (size_t)l * 3 * 256;
    for (int idx = bid_l() * 512 + tid_l(); idx < nrows * 32; idx += gridDim.x * 512) {
        const int row = idx >> 5, c8 = (idx & 31) * 8;
        bool hp, hn;
        if (row < RLAT) { const int pos = row & 63; hp = pos > 0; hn = pos < 63; } else { const int pos = (row - RLAT) & 255; hp = pos > 0; hn = pos < 255; }
        const bf16_t* pr = PB + (size_t)row * NP + c8;
        const u32x4 gb = *(const u32x4*)(pr + PCB);
        const u32x4 c1 = *(const u32x4*)(pr + PCC), h1 = *(const u32x4*)(pr + PCH);
        u32x4 c0 = (u32x4){0u, 0u, 0u, 0u}, h0 = c0, c2 = c0, h2 = c0;
        if (hp) { c0 = *(const u32x4*)(pr - NP + PCC); h0 = *(const u32x4*)(pr - NP + PCH); }
        if (hn) { c2 = *(const u32x4*)(pr + NP + PCC); h2 = *(const u32x4*)(pr + NP + PCH); }
        u32x4 o;
#pragma unroll
        for (int x = 0; x < 4; ++x) {
            const int c = c8 + 2 * x;
            const float ylo = cw[c] * (bflo(c0[x]) * bflo(h0[x])) + cw[256 + c] * (bflo(c1[x]) * bflo(h1[x])) + cw[512 + c] * (bflo(c2[x]) * bflo(h2[x]));
            const float yhi = cw[c + 1] * (bfhi(c0[x]) * bfhi(h0[x])) + cw[256 + c + 1] * (bfhi(c1[x]) * bfhi(h1[x])) + cw[512 + c + 1] * (bfhi(c2[x]) * bfhi(h2[x]));
            o[x] = cvt_pk_bf16(bflo(gb[x]) * ylo, bfhi(gb[x]) * yhi);
        }
        *(u32x4*)(ACT + (size_t)row * D + 512 + c8) = o;
    }
}

__device__ void combine_all(const Params& p, int l, int nrows) {
    const bf16_t* PB = (const bf16_t*)(p.ws + WS_PBUF); bf16_t* ACT = (bf16_t*)(p.ws + WS_ACT); const bf16_t* HB = (const bf16_t*)(p.ws + WS_HB);
    const float* mn = p.in[10] + (size_t)l * 512;
    for (int idx = bid_l() * 512 + tid_l(); idx < nrows * 64; idx += gridDim.x * 512) {
        const int row = idx >> 6, c8 = (idx & 63) * 8;
        const u32x4 a = *(const u32x4*)(ACT + (size_t)row * D + c8), bb = *(const u32x4*)(HB + (size_t)row * 512 + c8), og = *(const u32x4*)(PB + (size_t)row * NP + PO + c8);
        float f[8]; float ss = 0.f;
#pragma unroll
        for (int x = 0; x < 4; ++x) { f[2 * x] = bflo(a[x]) + bflo(bb[x]); f[2 * x + 1] = bfhi(a[x]) + bfhi(bb[x]); ss += f[2 * x] * f[2 * x] + f[2 * x + 1] * f[2 * x + 1]; }
#pragma unroll
        for (int o = 8; o >= 1; o >>= 1) ss += __shfl_xor(ss, o);
        const float rstd = rsqrtf(ss * (1.f / 128.f) + EPS);
        u32x4 o;
#pragma unroll
        for (int x = 0; x < 4; ++x) {
            const float o0 = 1.f / (1.f + __expf(-bflo(og[x]))), o1 = 1.f / (1.f + __expf(-bfhi(og[x])));
            o[x] = cvt_pk_bf16(o0 * f[2 * x] * rstd * mn[c8 + 2 * x], o1 * f[2 * x + 1] * rstd * mn[c8 + 2 * x + 1]);
        }
        *(u32x4*)(ACT + (size_t)row * D + c8) = o;
    }
}

#include <cstdio>
#include <cstdint>
#include <cstdlib>
#include <vector>

#define XB_TMO      128
#define XB_XCNT(j)  (256  + 64 * (j))
#define XB_XSUB(j)  (1280 + 64 * (j))
#define XB_XGEN(j)  (2304 + 64 * (j))
#define XB_TOP      3328
#define XB_TOPGEN   3392
#define XCD_BAR_WORDS 3456
#define XB_SPIN_CAP (1u << 18)

__device__ __forceinline__ unsigned xb_ld(unsigned* p)              { return __hip_atomic_load(p, __ATOMIC_RELAXED, __HIP_MEMORY_SCOPE_AGENT); }
__device__ __forceinline__ unsigned xb_add(unsigned* p, unsigned v) { return __hip_atomic_fetch_add(p, v, __ATOMIC_RELAXED, __HIP_MEMORY_SCOPE_AGENT); }
__device__ __forceinline__ unsigned xb_xcc_id() { return (unsigned)__builtin_amdgcn_s_getreg((3 << 11) | 20) & 0xFu; }
#define XB_SPIN(cond, bar) do { unsigned _sp = 0; while (cond) { __builtin_amdgcn_s_sleep(1); \
    if ((++_sp & 255u) == 0u) { if (xb_ld(&(bar)[XB_TMO])) break; if (_sp > XB_SPIN_CAP) { atomicAdd(&(bar)[XB_TMO], 1u); break; } } } } while (0)

struct XcdBarrier {
    unsigned* bar; unsigned x;
    volatile LAS unsigned* st;
};

__device__ __forceinline__ XcdBarrier xcd_barrier_post(unsigned* bar, volatile LAS unsigned* st) {
    XcdBarrier b; b.bar = bar; b.x = xb_xcc_id(); b.st = st;
    if (threadIdx.x == 0) (void)xb_add(&bar[XB_XCNT(b.x)], 1u);
    return b;
}
__device__ __forceinline__ void xcd_barrier_complete(unsigned* bar, unsigned x, unsigned& nloc, unsigned& nx) {
    const unsigned G = gridDim.x * gridDim.y * gridDim.z;
    unsigned sum, cnt, mine, sp = 0u;
    for (;;) {
        sum = 0u; cnt = 0u; mine = 0u;
#pragma unroll
        for (unsigned j = 0; j < 16; ++j) { const unsigned c = xb_ld(&bar[XB_XCNT(j)]); sum += c; cnt += (c > 0u) ? 1u : 0u; mine = (j == x) ? c : mine; }
        if (sum == G) break;
        __builtin_amdgcn_s_sleep(1);
        if ((++sp & 255u) == 0u) { if (xb_ld(&bar[XB_TMO])) break; if (sp > XB_SPIN_CAP) { atomicAdd(&bar[XB_TMO], 1u); break; } }
    }
    nloc = mine > 0u ? mine : 1u; nx = cnt > 0u ? cnt : 1u;
}

__device__ __forceinline__ void xcd_barrier(const XcdBarrier& b) {
    asm volatile("s_waitcnt vmcnt(0)" ::: "memory");
    __syncthreads();
    if (threadIdx.x == 0) {
        unsigned* bar = b.bar;
        __builtin_amdgcn_s_waitcnt(0);
        unsigned nloc = b.st[0], nx = b.st[1];
        if (nloc == 0u) { xcd_barrier_complete(bar, b.x, nloc, nx); b.st[0] = nloc; b.st[1] = nx; }
        const unsigned old = xb_add(&bar[XB_XSUB(b.x)], 1u);
        const unsigned gen = old / nloc;
        if (old + 1u == (gen + 1u) * nloc) {
            __builtin_amdgcn_fence(__ATOMIC_RELEASE, "agent");
            asm volatile("s_waitcnt vmcnt(0)" ::: "memory");
            const unsigned og = xb_add(&bar[XB_TOP], 1u);
            const unsigned tg = og / nx;
            if (og + 1u == (tg + 1u) * nx) xb_add(&bar[XB_TOPGEN], 1u);
            else XB_SPIN(xb_ld(&bar[XB_TOPGEN]) == tg, bar);
            __builtin_amdgcn_fence(__ATOMIC_ACQUIRE, "agent");
            xb_add(&bar[XB_XGEN(b.x)], 1u);
            asm volatile("s_waitcnt vmcnt(0)" ::: "memory");
        } else {
            XB_SPIN(xb_ld(&bar[XB_XGEN(b.x)]) == gen, bar);
            __builtin_amdgcn_fence(__ATOMIC_ACQUIRE, "agent");
            asm volatile("s_waitcnt vmcnt(0)" ::: "memory");
        }
    }
    __syncthreads();
}


__device__ __forceinline__ void run_phase(const Params& p, int ph, LAS unsigned char* lds) {
    if (ph == 0) { phase_prep(p, lds); return; }
    if (ph == NPHASE - 1) { phase_norm<2>(p, 0, RLAT, lds); return; }
    const int l = (ph - 1) >> 3, sub = (ph - 1) & 7; const bool last = (l == DEPTH - 1);
    const int nrows = last ? RLAT : ROWS;
    bf16_t* ACT = (bf16_t*)(p.ws + WS_ACT); bf16_t* PBUF = (bf16_t*)(p.ws + WS_PBUF);
    const bf16_t* WB = (const bf16_t*)(p.ws + WS_WB) + (size_t)l * WL_SZ;
    pg8::StaticOrder S;
    if (sub == 0) { phase_norm<0>(p, l, ROWS, lds); }
    else if (sub == 1) { pg8::Gemm g; g.A = ACT; g.Bt = WB + WL_IN; g.M = ROWS; g.N = NP; g.K = D; S.init(g.M, g.N, (int)gridDim.x, (int)bid_l());
        EpiP E; E.O = PBUF; E.ldc = NP; pg8::gemm_phase<EpiP, pg8::StaticOrder, false>(lds, g, S, E, nullptr); }
    else if (sub == 2) {
        for (int rep = 0; rep < ((PROBE >> 9) & 1) + 1; ++rep)
        for (int item = bid_l(); item < 256; item += gridDim.x) chain_item(p, item, last, lds);
        for (int rep = 0; rep < ((PROBE >> 10) & 1) + 1; ++rep) {
        for (int ch = bid_l(); ch < nrows / 128; ch += gridDim.x) gmlp_item(p, l, ch, lds);
        conv_all(p, l, nrows); }
    }
    else if (sub == 3) { combine_all(p, l, nrows); }
    else if (sub == 4 || sub == 7) { pg8::Gemm g; g.M = nrows; g.N = D;
        if (sub == 4) { g.A = ACT; g.Bt = WB + WL_OUT; g.K = D; } else { g.A = PBUF; g.Bt = WB + WL_2; g.K = DFF; }
        S.init(g.M, g.N, (int)gridDim.x, (int)bid_l());
        EpiResid E; E.xl = p.out; E.xc = (float*)(p.ws + WS_CTXW); E.modl = (const float*)(p.ws + WS_MOD) + (size_t)l * 17 * 6144; E.goff = sub == 4 ? 2048 : 5120;
        pg8::gemm_phase<EpiResid, pg8::StaticOrder, false>(lds, g, S, E, nullptr); }
    else if (sub == 5) { phase_norm<1>(p, l, nrows, lds); }
    else { pg8::Gemm g; g.A = ACT; g.Bt = WB + WL_13; g.M = nrows; g.N = 2 * DFF; g.K = D; S.init(g.M, g.N, (int)gridDim.x, (int)bid_l());
        EpiSwiglu E; E.O = PBUF; pg8::gemm_phase<EpiSwiglu, pg8::StaticOrder, false>(lds, g, S, E, nullptr); }
}

__global__ void __launch_bounds__(512, 2) fwd_kernel(Params p, int ph_lo, int ph_hi) {
    extern __shared__ __attribute__((aligned(16))) unsigned char shm[];
    LAS unsigned char* lds = (LAS unsigned char*)shm;
    cg::grid_group grid = cg::this_grid();
    volatile LAS unsigned* st = (volatile LAS unsigned*)(lds + LDS_BYTES - 16);
    if (threadIdx.x == 0) { st[0] = 0u; st[1] = 0u; }
    __syncthreads();
    const XcdBarrier xb = xcd_barrier_post((unsigned*)(p.ws + WS_BAR), st);
    for (int ph = ph_lo; ph < ph_hi; ++ph) {
        run_phase(p, ph, lds);
        if (PROBE) { const int sub = (ph - 1) & 7; const bool rep = (ph == 0) ? ((PROBE >> 8) & 1) : (ph < NPHASE - 1 && ((PROBE >> sub) & 1));
            if (rep) { if (ph == 0) grid.sync(); else xcd_barrier(xb); run_phase(p, ph, lds); } }
        if (ph + 1 < ph_hi) { if (ph == ph_lo) grid.sync(); else xcd_barrier(xb); }
    }
}

extern "C" void kernel_launch(void* const* d_in, const int* in_sizes, int n_in, void* d_out, int out_size, void* d_ws, size_t ws_size, hipStream_t stream) {
    static int grid = 0;
    if (grid == 0) {
        if (n_in != 20 || out_size != RLAT * D || ws_size < WS_END) { fprintf(stderr, "kernel_launch: unexpected shapes (n_in %d, out %d, ws %zu, need %zu)\n", n_in, out_size, ws_size, (size_t)WS_END); grid = -1; return; }
        int dev = 0, cus = 0, per_cu = 0;
        (void)hipGetDevice(&dev); (void)hipDeviceGetAttribute(&cus, hipDeviceAttributeMultiprocessorCount, dev);
        if (hipFuncSetAttribute((const void*)fwd_kernel, hipFuncAttributeMaxDynamicSharedMemorySize, LDS_BYTES) != hipSuccess) { fprintf(stderr, "kernel_launch: hipFuncSetAttribute failed\n"); grid = -1; return; }
        if (hipOccupancyMaxActiveBlocksPerMultiprocessor(&per_cu, (const void*)fwd_kernel, 512, LDS_BYTES) != hipSuccess || per_cu < 1) { fprintf(stderr, "kernel_launch: occupancy query failed (%d)\n", per_cu); (void)hipGetLastError(); per_cu = 1; }
        grid = cus * per_cu;
    }
    if (grid < 0) return;
    if (hipMemsetAsync((char*)d_ws + WS_BAR, 0, 16384, stream) != hipSuccess) { fprintf(stderr, "kernel_launch: memset of barrier words failed\n"); return; }
    Params p{};
    for (int i = 0; i < 20; ++i) p.in[i] = (const float*)d_in[i];
    p.out = (float*)d_out; p.ws = (unsigned char*)d_ws;
    int lo = 0, hi = NPHASE;
    void* args[] = {&p, &lo, &hi};
    hipError_t e = hipLaunchCooperativeKernel((const void*)fwd_kernel, dim3(grid), dim3(512), args, LDS_BYTES, stream);
    if (e != hipSuccess) fprintf(stderr, "kernel_launch: cooperative launch failed: %s (grid %d)\n", hipGetErrorString(e), grid);
}
```

```cpp
#include <hip/hip_runtime.h>
#include <hip/hip_cooperative_groups.h>
#include <cstdio>
namespace cg = cooperative_groups;
__device__ __forceinline__ int tid_l() { int t = threadIdx.x; asm volatile("" : "+v"(t)); return t; }
__device__ __forceinline__ int bid_l() { int t = blockIdx.x; asm volatile("" : "+s"(t)); return t; }
namespace pg8 {
#define PG8_LAS __attribute__((address_space(3)))
typedef unsigned short bf16_t;
typedef short bf16x8 __attribute__((ext_vector_type(8)));
typedef float f32x4 __attribute__((ext_vector_type(4)));
typedef unsigned u32x4 __attribute__((ext_vector_type(4)));
constexpr int BM = 256, BK = 64, HALF = 128, HTB = HALF * BK * 2  , STAGE_BYTES = 8 * HTB, NXCD = 8, WGM = 8;

__host__ __device__ __forceinline__ int lds_byte(int r, int c) { const int st = (r >> 4) * 2 + (c >> 5), rr = r & 15, cc = c & 31, ob = rr * 64 + cc * 2; return st * 1024 + (ob ^ (((ob >> 9) & 1) << 5)); }
__host__ __device__ __forceinline__ void stage_rc(int b, int& R, int& C) { const int st = b / 1024, sb = b % 1024, swz = sb ^ (((sb >> 9) & 1) << 5); R = (st >> 1) * 16 + swz / 64; C = (st & 1) * 32 + (swz % 64) / 2; }
__host__ __device__ __forceinline__ int perm32(int rho) { const int n = rho >> 4, i = rho & 15; return 8 * (i >> 2) + 4 * n + (i & 3); }

struct Unit { int pm, pn, k0, nt; };
struct Gemm { const bf16_t* A; const bf16_t* Bt; int M, N, K; };

struct StaticOrder {
    int nM, nN, nwg, G, c, ntk;
    __host__ __device__ void init(int M, int N, int G_, int c_) { nM = M / BM; nN = N / BM; nwg = nM * nN; G = G_; c = c_; }
    __host__ __device__ bool next(int i, Unit& u) const {
        const long L = (long)i * G + c; if (L >= nwg) return false;
        int wgid = (int)L; { const int q = nwg / NXCD, r = nwg % NXCD, xcd = wgid % NXCD, off = wgid / NXCD; wgid = (xcd < r ? xcd * (q + 1) : r * (q + 1) + (xcd - r) * q) + off; }
        const int nig = WGM * nN, gid = wgid / nig, fm = gid * WGM, gsz = (nM - fm) < WGM ? (nM - fm) : WGM;
        u.pm = fm + ((wgid % nig) % gsz); u.pn = (wgid % nig) / gsz; u.k0 = 0; u.nt = ntk; return true;
    }
    __device__ __forceinline__ void a_ready(const Unit&) const {}
    __device__ __forceinline__ void done(const Unit&) const {}
};
__device__ __forceinline__ unsigned cvt_pk_bf16(float lo, float hi) { unsigned r; asm volatile("v_cvt_pk_bf16_f32 %0, %1, %2" : "=v"(r) : "v"(lo), "v"(hi)); return r; }
template <class Epi, class Sched, bool STAMP = false>
__device__ __forceinline__ void gemm_phase(PG8_LAS unsigned char* lds, const Gemm g, const Sched& S, const Epi& E, unsigned long long* stamps) {
    const int tid = tid_l(), wid = __builtin_amdgcn_readfirstlane(tid >> 6), lane = tid & 63, wr = wid >> 2, wc = wid & 3, fr = lane & 15, fq = lane >> 4;
    const int K = g.K;
    int ts_lo = 0, ts_hi = 0, nts = 0; const unsigned long long rt_entry = STAMP ? (unsigned long long)wall_clock64() : 0ull;
#define PG8_STAMP() do { if (STAMP && wid == 0 && nts < 64) { const unsigned long long _c = (unsigned long long)clock64(); \
        ts_lo = (lane == nts) ? (int)(unsigned)_c : ts_lo; ts_hi = (lane == nts) ? (int)(unsigned)(_c >> 32) : ts_hi; ++nts; } } while (0)
    PG8_STAMP();
    unsigned voffA[2], voffB[2];
#pragma unroll
    for (int i = 0; i < 2; ++i) { int R, C; stage_rc(tid * 16 + i * 8192, R, C); const int Rb = Epi::PERM ? ((R & ~31) + perm32(R & 31)) : R;
        voffA[i] = (unsigned)(R * K + C) * 2u; voffB[i] = (unsigned)(Rb * K + C) * 2u; }
    const size_t kstep = (size_t)(BK * 2);
    const size_t hstep = (size_t)HALF * K * 2;
    const size_t tstep = 2 * hstep;
    const unsigned ldsw = (unsigned)wid * 1024u;
    const int aoff = lds_byte(wr * 64 + fr, fq * 8), boff = lds_byte(wc * 32 + fr, fq * 8);
#define PG8_SA(b, h) (((b) * 2 + (h)) * HTB)
#define PG8_SB(b, h) ((4 + (b) * 2 + (h)) * HTB)
#define PG8_STAGE(bufoff, gbase, voff) do { _Pragma("unroll") for (int _i = 0; _i < 2; ++_i) \
        __builtin_amdgcn_global_load_lds((const unsigned*)((const char*)(gbase) + (voff)[_i]), (PG8_LAS unsigned*)(lds + (bufoff) + ldsw + _i * 8192), 16, 0, 0); } while (0)
#define PG8_LDA(dst, b, h) do { _Pragma("unroll") for (int m = 0; m < 4; ++m) _Pragma("unroll") for (int k = 0; k < 2; ++k) dst[m][k] = *(const PG8_LAS bf16x8*)(lds + PG8_SA(b, h) + aoff + m * 2048 + k * 1024); } while (0)
#define PG8_LDB(dst, b, h) do { _Pragma("unroll") for (int n = 0; n < 2; ++n) _Pragma("unroll") for (int k = 0; k < 2; ++k) dst[n][k] = *(const PG8_LAS bf16x8*)(lds + PG8_SB(b, h) + boff + n * 2048 + k * 1024); } while (0)
#define PG8_MMA(ai, bj, At, Bt) do { __builtin_amdgcn_s_setprio(1); _Pragma("unroll") for (int m = 0; m < 4; ++m) _Pragma("unroll") for (int n = 0; n < 2; ++n) _Pragma("unroll") for (int k = 0; k < 2; ++k) \
        acc[ai][bj][m][n] = __builtin_amdgcn_mfma_f32_16x16x32_bf16(Bt[n][k], At[m][k], acc[ai][bj][m][n], 0, 0, 0); __builtin_amdgcn_s_setprio(0); } while (0)
#define PG8_WAIT_V(n) asm volatile("s_waitcnt vmcnt(" #n ")" ::: "memory")
#define PG8_WAIT_L(n) asm volatile("s_waitcnt lgkmcnt(" #n ")" ::: "memory")
#define PG8_BAR __builtin_amdgcn_s_barrier()
#define PG8_SCHED __builtin_amdgcn_sched_barrier(0)
    Unit cur, nxt; int ui = 0;
    if (!S.next(0, cur)) return;
    f32x4 acc[2][2][4][2];
#pragma unroll
    for (int a = 0; a < 2; ++a)
#pragma unroll
        for (int b = 0; b < 2; ++b)
#pragma unroll
            for (int m = 0; m < 4; ++m)
#pragma unroll
                for (int n = 0; n < 2; ++n) acc[a][b][m][n] = (f32x4){0.f, 0.f, 0.f, 0.f};
    bf16x8 At[4][2], B0[2][2], B1[2][2];
    const char* cA = (const char*)g.A + (size_t)cur.pm * tstep + (size_t)cur.k0 * kstep; const char* cB = (const char*)g.Bt + (size_t)cur.pn * tstep + (size_t)cur.k0 * kstep;
    S.a_ready(cur);
    PG8_STAGE(PG8_SB(0, 0), cB, voffB); PG8_STAGE(PG8_SA(0, 0), cA, voffA); PG8_STAGE(PG8_SB(0, 1), cB + hstep, voffB); PG8_STAGE(PG8_SA(0, 1), cA + hstep, voffA);
    if (wr == 1) PG8_BAR;
    PG8_WAIT_V(4); PG8_BAR;
    PG8_STAGE(PG8_SB(1, 0), cB + kstep, voffB); PG8_STAGE(PG8_SA(1, 0), cA + kstep, voffA); PG8_STAGE(PG8_SB(1, 1), cB + hstep + kstep, voffB);
    PG8_WAIT_V(6); PG8_BAR;
    PG8_STAMP();
    for (;;) {
        const bool has_next = S.next(ui + 1, nxt);
        const char* nA = has_next ? (const char*)g.A + (size_t)nxt.pm * tstep + (size_t)nxt.k0 * kstep : cA; const char* nB = has_next ? (const char*)g.Bt + (size_t)nxt.pn * tstep + (size_t)nxt.k0 * kstep : cB;
        const int nt = cur.nt;
        for (int t = 0; t < nt; t += 2) {
            const bool last = (t == nt - 2);
            const char* a1 = cA + (size_t)(t + 1) * kstep;
            const char* a2 = last ? nA : cA + (size_t)(t + 2) * kstep; const char* b2 = last ? nB : cB + (size_t)(t + 2) * kstep;
            const char* a3 = a2 + kstep; const char* b3 = b2 + kstep;
            if (last && has_next) S.a_ready(nxt);
            PG8_LDB(B0, 0, 0); PG8_SCHED; PG8_LDA(At, 0, 0); PG8_STAGE(PG8_SA(1, 1), a1 + hstep, voffA);
            PG8_WAIT_L(8); PG8_BAR; PG8_WAIT_L(0); PG8_MMA(0, 0, At, B0); PG8_BAR; PG8_SCHED;
            PG8_LDB(B1, 0, 1); PG8_STAGE(PG8_SB(0, 0), b2, voffB);
            PG8_BAR; PG8_WAIT_L(0); PG8_MMA(0, 1, At, B1); PG8_BAR;
            PG8_LDA(At, 0, 1); PG8_STAGE(PG8_SA(0, 0), a2, voffA);
            PG8_BAR; PG8_WAIT_L(0); PG8_MMA(1, 0, At, B0); PG8_BAR; PG8_SCHED;
            PG8_STAGE(PG8_SB(0, 1), b2 + hstep, voffB);
            PG8_WAIT_V(6); PG8_BAR; PG8_MMA(1, 1, At, B1); PG8_BAR;
            PG8_LDB(B0, 1, 0); PG8_SCHED; PG8_LDA(At, 1, 0); PG8_STAGE(PG8_SA(0, 1), a2 + hstep, voffA);
            PG8_WAIT_L(8); PG8_BAR; PG8_WAIT_L(0); PG8_MMA(0, 0, At, B0); PG8_BAR; PG8_SCHED;
            PG8_LDB(B1, 1, 1); PG8_STAGE(PG8_SB(1, 0), b3, voffB);
            PG8_BAR; PG8_WAIT_L(0); PG8_MMA(0, 1, At, B1); PG8_BAR;
            PG8_LDA(At, 1, 1); PG8_STAGE(PG8_SA(1, 0), a3, voffA);
            PG8_BAR; PG8_WAIT_L(0); PG8_MMA(1, 0, At, B0); PG8_BAR; PG8_SCHED;
            PG8_STAGE(PG8_SB(1, 1), b3 + hstep, voffB);
            PG8_WAIT_V(6); PG8_BAR; PG8_MMA(1, 1, At, B1); PG8_BAR;
        }
        PG8_STAMP();
        if constexpr (!Epi::AFTER_DRAIN) { E(acc, cur, wr, wc, fr, fq); S.done(cur); }
        PG8_STAMP();
        if (!has_next) break;
#pragma unroll
        for (int a = 0; a < 2; ++a)
#pragma unroll
            for (int b = 0; b < 2; ++b)
#pragma unroll
                for (int m = 0; m < 4; ++m)
#pragma unroll
                    for (int n = 0; n < 2; ++n) acc[a][b][m][n] = (f32x4){0.f, 0.f, 0.f, 0.f};
        cur = nxt; cA = nA; cB = nB; ++ui;
    }
    PG8_WAIT_V(0);
    if (wr == 0) PG8_BAR;
    PG8_BAR;
    if constexpr (Epi::AFTER_DRAIN) { E.fused(acc, cur, wr, wc, fr, fq, lds, wid, lane); S.done(cur); }
    PG8_STAMP();
    if (STAMP && wid == 0) { stamps[lane] = lane < nts ? (((unsigned long long)(unsigned)ts_hi << 32) | (unsigned)ts_lo) : 0ull;
        if (lane == 62) stamps[62] = rt_entry; if (lane == 63) stamps[63] = (unsigned long long)wall_clock64(); }
#undef PG8_STAMP
#undef PG8_SA
#undef PG8_SB
#undef PG8_STAGE
#undef PG8_LDA
#undef PG8_LDB
#undef PG8_MMA
#undef PG8_WAIT_V
#undef PG8_WAIT_L
#undef PG8_BAR
#undef PG8_SCHED
}
}

using pg8::bf16_t; using pg8::bf16x8; using pg8::f32x4; using pg8::u32x4; using pg8::cvt_pk_bf16; using pg8::Unit;
#define LAS __attribute__((address_space(3)))
typedef unsigned u32x2 __attribute__((ext_vector_type(2)));

constexpr int D = 1024, NBATCH = 16, SEQ = 2048, CTXL = 256, DEPTH = 4, DIN = 3344, NP = 3328, DFF = 2816;
constexpr int RLAT = NBATCH * SEQ, RCTX = NBATCH * CTXL, ROWS = RLAT + RCTX;
constexpr int PK = 0, PV = 512, PQ = 1024, PO = 1536, PCB = 2048, PCC = 2304, PCH = 2560, PGU = 2816, PGV = 3072;
constexpr float EPS = 1e-6f;
constexpr int LDS_BYTES = 147456;
#ifndef PROBE
#define PROBE 0
#endif
constexpr int NPHASE = 2 + 8 * DEPTH;
constexpr size_t WS_XB = 0;
constexpr size_t WS_ACT = WS_XB + (size_t)ROWS * D * 2;
constexpr size_t WS_PBUF = WS_ACT + (size_t)ROWS * D * 2;
constexpr size_t WS_GATES = WS_PBUF + (size_t)ROWS * NP * 2;
constexpr size_t OUT_SCR = (size_t)ROWS * 512 * 2;
constexpr size_t WS_MOD = WS_GATES + (size_t)ROWS * 16 * 4;
constexpr size_t WS_WB = WS_MOD + (size_t)DEPTH * 17 * 6144 * 4;
constexpr size_t WL_IN = 0, WL_OUT = (size_t)NP * D, WL_13 = WL_OUT + (size_t)D * D, WL_2 = WL_13 + (size_t)2 * DFF * D, WL_SZ = WL_2 + (size_t)D * DFF;
constexpr size_t WS_BAR = WS_WB + (size_t)DEPTH * WL_SZ * 2;
constexpr size_t WS_END = WS_BAR + 16384;

struct Params { const float* in[20]; float* out; unsigned char* ws; };

__device__ __forceinline__ float bflo(unsigned u) { return __uint_as_float(u << 16); }
__device__ __forceinline__ float bfhi(unsigned u) { return __uint_as_float(u & 0xffff0000u); }
__device__ __forceinline__ float bf2f(short v) { return __uint_as_float(((unsigned)(unsigned short)v) << 16); }
__device__ __forceinline__ f32x4 mfma16(bf16x8 a, bf16x8 b, f32x4 c) { return __builtin_amdgcn_mfma_f32_16x16x32_bf16(a, b, c, 0, 0, 0); }
__device__ __forceinline__ float silu_f(float a) { return a * __builtin_amdgcn_rcpf(1.f + __expf(-a)); }

struct EpiP {
    static constexpr bool PERM = true, AFTER_DRAIN = false;
    bf16_t* O; int ldc;
    __device__ __forceinline__ void operator()(const f32x4 (&acc)[2][2][4][2], const Unit& u, int wr, int wc, int fr, int fq) const {
        const int row0 = u.pm * 256 + wr * 64 + fr, col0 = u.pn * 256 + wc * 32 + 8 * fq;
#pragma unroll
        for (int ai = 0; ai < 2; ++ai)
#pragma unroll
            for (int m = 0; m < 4; ++m) { bf16_t* rowp = O + (size_t)(row0 + ai * 128 + m * 16) * ldc + col0;
#pragma unroll
                for (int bj = 0; bj < 2; ++bj) { const f32x4 v0 = acc[ai][bj][m][0], v1 = acc[ai][bj][m][1];
                    u32x4 w; w.x = cvt_pk_bf16(v0[0], v0[1]); w.y = cvt_pk_bf16(v0[2], v0[3]); w.z = cvt_pk_bf16(v1[0], v1[1]); w.w = cvt_pk_bf16(v1[2], v1[3]);
                    *(u32x4*)(rowp + bj * 128) = w; } }
    }
};
struct EpiSwiglu {
    static constexpr bool PERM = true, AFTER_DRAIN = false;
    bf16_t* O;
    __device__ __forceinline__ void operator()(const f32x4 (&acc)[2][2][4][2], const Unit& u, int wr, int wc, int fr, int fq) const {
        const int row0 = u.pm * 256 + wr * 64 + fr, col0 = u.pn * 128 + wc * 32 + 8 * fq;
#pragma unroll
        for (int ai = 0; ai < 2; ++ai)
#pragma unroll
            for (int m = 0; m < 4; ++m) { bf16_t* rowp = O + (size_t)(row0 + ai * 128 + m * 16) * DFF + col0;
                const f32x4 a0 = acc[ai][0][m][0], a1 = acc[ai][0][m][1], b0 = acc[ai][1][m][0], b1 = acc[ai][1][m][1];
                u32x4 w;
                w.x = cvt_pk_bf16(silu_f(a0[0]) * b0[0], silu_f(a0[1]) * b0[1]); w.y = cvt_pk_bf16(silu_f(a0[2]) * b0[2], silu_f(a0[3]) * b0[3]);
                w.z = cvt_pk_bf16(silu_f(a1[0]) * b1[0], silu_f(a1[1]) * b1[1]); w.w = cvt_pk_bf16(silu_f(a1[2]) * b1[2], silu_f(a1[3]) * b1[3]);
                *(u32x4*)rowp = w; }
    }
};
struct EpiResid {
    static constexpr bool PERM = true, AFTER_DRAIN = false;
    bf16_t* xb; const float* modl; int goff; float gscale;
    __device__ __forceinline__ void operator()(const f32x4 (&acc)[2][2][4][2], const Unit& u, int wr, int wc, int fr, int fq) const {
        const int row0 = u.pm * 256 + wr * 64 + fr, col0 = u.pn * 256 + wc * 32 + 8 * fq;
        bf16_t* X = xb + (size_t)row0 * D + col0;
        const float* gp = modl + (size_t)(u.pm < 128 ? (u.pm >> 3) : 16) * 6144 + goff + col0;
        f32x4 gv[2][2];
#pragma unroll
        for (int bj = 0; bj < 2; ++bj)
#pragma unroll
            for (int n = 0; n < 2; ++n) gv[bj][n] = *(const f32x4*)(gp + bj * 128 + 4 * n) * gscale;
#pragma unroll
        for (int ai = 0; ai < 2; ++ai)
#pragma unroll
            for (int m = 0; m < 4; ++m) { bf16_t* rowp = X + (size_t)(ai * 128 + m * 16) * D;
#pragma unroll
                for (int bj = 0; bj < 2; ++bj) { const u32x4 xw = *(const u32x4*)(rowp + bj * 128);
                    const f32x4 v0 = gv[bj][0] * acc[ai][bj][m][0] + (f32x4){bflo(xw.x), bfhi(xw.x), bflo(xw.y), bfhi(xw.y)};
                    const f32x4 v1 = gv[bj][1] * acc[ai][bj][m][1] + (f32x4){bflo(xw.z), bfhi(xw.z), bflo(xw.w), bfhi(xw.w)};
                    u32x4 o; o.x = cvt_pk_bf16(v0[0], v0[1]); o.y = cvt_pk_bf16(v0[2], v0[3]); o.z = cvt_pk_bf16(v1[0], v1[1]); o.w = cvt_pk_bf16(v1[2], v1[3]);
                    *(u32x4*)(rowp + bj * 128) = o; } }
    }
};
struct SplitOrder {
    int G, c, ntk;
    __device__ __forceinline__ bool next(int i, Unit& u) const {
        const int L = i * G + c; if (L >= 256) return false;
        const int tile = L >> 2, ks = L & 3;
        u.pm = 128 + (tile >> 2); u.pn = tile & 3;
        if (ntk == 16) { u.k0 = 4 * ks; u.nt = 4; } else { u.k0 = 11 * ks + (ks & 1); u.nt = 12 - 2 * (ks & 1); }
        return true;
    }
    __device__ __forceinline__ void a_ready(const Unit&) const {}
    __device__ __forceinline__ void done(const Unit&) const {}
};
struct EpiPartial {
    static constexpr bool PERM = false, AFTER_DRAIN = false;
    float* scr; const float* modl; int goff;
    __device__ __forceinline__ void operator()(const f32x4 (&acc)[2][2][4][2], const Unit& u, int wr, int wc, int fr, int fq) const {
        const int row0 = u.pm * 256 + wr * 64 + fr, col0 = u.pn * 256 + wc * 32 + 4 * fq;
        const int ks = (u.nt == 4) ? (u.k0 >> 2) : (u.k0 + 2) / 12;
        float* X = scr + ((size_t)ks * RCTX + (size_t)(row0 - RLAT)) * D;
        const float* gp = modl + (size_t)16 * 6144 + goff + col0;
        f32x4 gv[2][2];
#pragma unroll
        for (int bj = 0; bj < 2; ++bj)
#pragma unroll
            for (int n = 0; n < 2; ++n) gv[bj][n] = *(const f32x4*)(gp + bj * 128 + n * 16);
#pragma unroll
        for (int ai = 0; ai < 2; ++ai)
#pragma unroll
            for (int m = 0; m < 4; ++m) { float* rowp = X + (size_t)(ai * 128 + m * 16) * D + col0;
#pragma unroll
                for (int bj = 0; bj < 2; ++bj)
#pragma unroll
                    for (int n = 0; n < 2; ++n) *(f32x4*)(rowp + bj * 128 + n * 16) = gv[bj][n] * acc[ai][bj][m][n]; }
    }
};

__device__ void phase_prep(const Params& p, LAS unsigned char* lds) {
    const int tid = tid_l(), w = tid >> 6, lane = tid & 63;
    float* MOD = (float*)(p.ws + WS_MOD);
    {
        LAS float* S = (LAS float*)lds;
        LAS float* R = S + 17 * 1024;
        for (int i = tid; i < 17 * 1024; i += 512) { const int r = i >> 10, k = i & 1023; const float v = r < 16 ? p.in[1][r * 1024 + k] : p.in[3][k]; S[i] = v / (1.f + expf(-v)); }
        __syncthreads();
        for (int item = bid_l(); item < 384; item += gridDim.x) {
            const int l = item / 96, n0 = (item % 96) * 64;
            const float* wa = p.in[4] + (size_t)l * 1024 * 6144 + n0 + lane;
            float acc[17];
#pragma unroll
            for (int r = 0; r < 17; ++r) acc[r] = 0.f;
            for (int k4 = 0; k4 < 32; ++k4) {
                const int k = w * 128 + k4 * 4;
                const float w0 = wa[(size_t)k * 6144], w1 = wa[(size_t)(k + 1) * 6144], w2 = wa[(size_t)(k + 2) * 6144], w3 = wa[(size_t)(k + 3) * 6144];
#pragma unroll
                for (int r = 0; r < 17; ++r) { const f32x4 s = *(const LAS f32x4*)(S + r * 1024 + k); acc[r] += s[0] * w0 + s[1] * w1 + s[2] * w2 + s[3] * w3; }
            }
#pragma unroll
            for (int r = 0; r < 17; ++r) R[(w * 17 + r) * 64 + lane] = acc[r];
            __syncthreads();
            for (int o = tid; o < 17 * 64; o += 512) { const int r = o >> 6, n = o & 63; float s = 0.f;
#pragma unroll
                for (int ww = 0; ww < 8; ++ww) s += R[(ww * 17 + r) * 64 + n];
                MOD[((size_t)l * 17 + r) * 6144 + n0 + n] = s + p.in[5][l * 6144 + n0 + n]; }
            __syncthreads();
        }
    }
    {
        LAS float* T = (LAS float*)lds;
        for (int item = bid_l(); item < DEPTH * 3200; item += gridDim.x) {
            const int l = item / 3200; int j = item % 3200;
            bf16_t* WB = (bf16_t*)(p.ws + WS_WB) + (size_t)l * WL_SZ;
            const float* src; int ld, col0, k0, K; bf16_t* dst; float scale = 1.f;
            if (j < 832) { const int n0 = (j >> 4) * 64; k0 = (j & 15) * 64; src = p.in[8] + (size_t)l * D * DIN; ld = DIN; col0 = n0 < 1024 ? n0 : n0 + 16; K = D; dst = WB + WL_IN + (size_t)n0 * D; if (n0 < 512) scale = 0.08838834764831845f; }
            else if (j < 1088) { j -= 832; const int n0 = (j >> 4) * 64; k0 = (j & 15) * 64; src = p.in[15] + (size_t)l * D * D; ld = D; col0 = n0; K = D; dst = WB + WL_OUT + (size_t)n0 * D; }
            else if (j < 2496) { j -= 1088; const int n0 = (j >> 4) * 64; k0 = (j & 15) * 64; const int pn = n0 >> 8, bj = (n0 >> 7) & 1, r0 = n0 & 127;
                src = (bj ? p.in[17] : p.in[16]) + (size_t)l * D * DFF; ld = DFF; col0 = pn * 128 + r0; K = D; dst = WB + WL_13 + (size_t)n0 * D; }
            else { j -= 2496; const int n0 = (j / 44) * 64; k0 = (j % 44) * 64; src = p.in[18] + (size_t)l * DFF * D; ld = D; col0 = n0; K = DFF; dst = WB + WL_2 + (size_t)n0 * DFF; }
#pragma unroll
            for (int hh = 0; hh < 2; ++hh) { const int k = (tid >> 4) + 32 * hh, n4 = (tid & 15) * 4;
                const f32x4 v = *(const f32x4*)(src + (size_t)(k0 + k) * ld + col0 + n4);
                T[k * 65 + n4] = v[0] * scale; T[k * 65 + n4 + 1] = v[1] * scale; T[k * 65 + n4 + 2] = v[2] * scale; T[k * 65 + n4 + 3] = v[3] * scale; }
            __syncthreads();
            { const int n = tid >> 3, k8 = (tid & 7) * 8; u32x4 o;
                o.x = cvt_pk_bf16(T[(k8 + 0) * 65 + n], T[(k8 + 1) * 65 + n]); o.y = cvt_pk_bf16(T[(k8 + 2) * 65 + n], T[(k8 + 3) * 65 + n]);
                o.z = cvt_pk_bf16(T[(k8 + 4) * 65 + n], T[(k8 + 5) * 65 + n]); o.w = cvt_pk_bf16(T[(k8 + 6) * 65 + n], T[(k8 + 7) * 65 + n]);
                *(u32x4*)(dst + (size_t)n * K + k0 + k8) = o; }
            __syncthreads();
        }
    }
    {
        u32x2* xd = (u32x2*)(p.ws + WS_XB);
        const f32x4* xs = (const f32x4*)p.in[0];
        for (size_t i = (size_t)bid_l() * 512 + tid; i < (size_t)RLAT * D / 4; i += (size_t)gridDim.x * 512) { const f32x4 v = xs[i]; u32x2 o; o.x = cvt_pk_bf16(v[0], v[1]); o.y = cvt_pk_bf16(v[2], v[3]); xd[i] = o; }
        const f32x4* cs = (const f32x4*)p.in[2]; u32x2* cd = xd + (size_t)RLAT * D / 4;
        for (size_t i = (size_t)bid_l() * 512 + tid; i < (size_t)RCTX * D / 4; i += (size_t)gridDim.x * 512) { const f32x4 v = cs[i]; u32x2 o; o.x = cvt_pk_bf16(v[0], v[1]); o.y = cvt_pk_bf16(v[2], v[3]); cd[i] = o; }
    }
}

__device__ __forceinline__ void gates_row(const f32x4 (&y)[4], const LAS float* Wgt, int lane, float* gout, const float* bg) {
    float gv[16];
#pragma unroll
    for (int n = 0; n < 16; ++n) { float f = 0.f;
#pragma unroll
        for (int j = 0; j < 4; ++j) { const f32x4 wv = *(const LAS f32x4*)(Wgt + n * 1024 + j * 256 + lane * 4); f += y[j][0] * wv[0] + y[j][1] * wv[1] + y[j][2] * wv[2] + y[j][3] * wv[3]; }
        gv[n] = f; }
    { const bool hi = lane & 32;
#pragma unroll
        for (int i = 0; i < 8; ++i) { const float send = hi ? gv[i] : gv[i + 8], keep = hi ? gv[i + 8] : gv[i]; gv[i] = keep + __shfl_xor(send, 32); } }
    { const bool hi = lane & 16;
#pragma unroll
        for (int i = 0; i < 4; ++i) { const float send = hi ? gv[i] : gv[i + 4], keep = hi ? gv[i + 4] : gv[i]; gv[i] = keep + __shfl_xor(send, 16); } }
    { const bool hi = lane & 8;
#pragma unroll
        for (int i = 0; i < 2; ++i) { const float send = hi ? gv[i] : gv[i + 2], keep = hi ? gv[i + 2] : gv[i]; gv[i] = keep + __shfl_xor(send, 8); } }
    { const bool hi = lane & 4; const float send = hi ? gv[0] : gv[1], keep = hi ? gv[1] : gv[0]; gv[0] = keep + __shfl_xor(send, 4); }
    gv[0] += __shfl_xor(gv[0], 2); gv[0] += __shfl_xor(gv[0], 1);
    const int n = (lane >> 2) & 15;
    if ((lane & 3) == 0) gout[n] = gv[0] + bg[n];
}
template <int MODE> __device__ void phase_norm(const Params& p, int l, int nrows, bool parts, LAS unsigned char* lds) {
    const int tid = tid_l(), w = tid >> 6, lane = tid & 63;
    LAS float* Wgt = (LAS float*)lds;
    if (MODE == 0) { const float* wi = p.in[8] + (size_t)l * D * DIN + 1024;
        for (int i = tid; i < 16384; i += 512) { const int k = i >> 4, n = i & 15; Wgt[n * 1024 + k] = wi[(size_t)k * DIN + n]; }
        __syncthreads(); }
    const float* nw = MODE == 0 ? p.in[6] + l * D : (MODE == 1 ? p.in[7] + l * D : p.in[19]);
    const float* MOD = (const float*)(p.ws + WS_MOD) + (size_t)l * 17 * 6144;
    bf16_t* ACT = (bf16_t*)(p.ws + WS_ACT); float* GATES = (float*)(p.ws + WS_GATES); bf16_t* XB = (bf16_t*)(p.ws + WS_XB);
    f32x4 nv[4];
#pragma unroll
    for (int j = 0; j < 4; ++j) nv[j] = *(const f32x4*)(nw + j * 256 + lane * 4);
    const int rstride = gridDim.x * 8;
    for (int rowa = bid_l() * 8 + w; rowa < nrows; rowa += 2 * rstride) {
        f32x4 xv[2][4]; float rstd[2];
#pragma unroll
        for (int q = 0; q < 2; ++q) { const int row = rowa + q * rstride; bf16_t* xr = XB + (size_t)row * D + lane * 4;
#pragma unroll
            for (int j = 0; j < 4; ++j) { const u32x2 u = *(const u32x2*)(xr + j * 256); xv[q][j] = (f32x4){bflo(u.x), bfhi(u.x), bflo(u.y), bfhi(u.y)}; }
            if (MODE != 2 && parts && row >= RLAT) {
                const float* sp = (const float*)((const unsigned char*)p.out + OUT_SCR) + (size_t)(row - RLAT) * D + lane * 4;
#pragma unroll
                for (int j = 0; j < 4; ++j) { xv[q][j] += *(const f32x4*)(sp + j * 256) + *(const f32x4*)(sp + (size_t)RCTX * D + j * 256) + *(const f32x4*)(sp + (size_t)2 * RCTX * D + j * 256) + *(const f32x4*)(sp + (size_t)3 * RCTX * D + j * 256);
                    u32x2 o; o.x = cvt_pk_bf16(xv[q][j][0], xv[q][j][1]); o.y = cvt_pk_bf16(xv[q][j][2], xv[q][j][3]); *(u32x2*)(xr + j * 256) = o;
                    xv[q][j] = (f32x4){bflo(o.x), bfhi(o.x), bflo(o.y), bfhi(o.y)}; } } }
#pragma unroll
        for (int q = 0; q < 2; ++q) { float ss = 0.f;
#pragma unroll
            for (int j = 0; j < 4; ++j) ss += xv[q][j][0] * xv[q][j][0] + xv[q][j][1] * xv[q][j][1] + xv[q][j][2] * xv[q][j][2] + xv[q][j][3] * xv[q][j][3];
#pragma unroll
            for (int o = 32; o >= 1; o >>= 1) ss += __shfl_xor(ss, o);
            rstd[q] = rsqrtf(ss * (1.f / 1024.f) + EPS); }
        if (MODE == 2) {
#pragma unroll
            for (int q = 0; q < 2; ++q)
#pragma unroll
                for (int j = 0; j < 4; ++j) *(f32x4*)(p.out + (size_t)(rowa + q * rstride) * D + j * 256 + lane * 4) = xv[q][j] * rstd[q] * nv[j];
            continue;
        }
        f32x4 y[2][4];
#pragma unroll
        for (int q = 0; q < 2; ++q) { const int row = rowa + q * rstride;
            const float* mr = MOD + (size_t)(row < RLAT ? (row >> 11) : 16) * 6144 + (MODE == 0 ? 0 : 3072);
#pragma unroll
            for (int j = 0; j < 4; ++j) { const f32x4 sh = *(const f32x4*)(mr + j * 256 + lane * 4), scl = *(const f32x4*)(mr + 1024 + j * 256 + lane * 4);
                y[q][j] = xv[q][j] * rstd[q] * nv[j] * (scl + 1.f) + sh;
                u32x2 o; o.x = cvt_pk_bf16(y[q][j][0], y[q][j][1]); o.y = cvt_pk_bf16(y[q][j][2], y[q][j][3]);
                *(u32x2*)(ACT + (size_t)row * D + j * 256 + lane * 4) = o; } }
        if (MODE == 0) {
            gates_row(y[0], Wgt, lane, GATES + (size_t)rowa * 16, p.in[9] + l * 16);
            __builtin_amdgcn_sched_barrier(0);
            gates_row(y[1], Wgt, lane, GATES + (size_t)(rowa + rstride) * 16, p.in[9] + l * 16);
        }
    }
}

typedef short s16x4 __attribute__((ext_vector_type(4)));
__device__ __forceinline__ unsigned offb(unsigned row, unsigned ch) { return 256u * row + 16u * (ch ^ (((row & 3u) << 2) | ((row >> 2) & 3u))); }
__device__ __forceinline__ bf16x8 rd_row(const LAS unsigned char* img, unsigned row, unsigned ch) { return *(const LAS bf16x8*)(img + offb(row, ch)); }
__device__ __forceinline__ bf16x8 rd_tr(const LAS unsigned char* img, unsigned lane, unsigned c, unsigned ks) {
    const unsigned g = lane >> 4, q = (lane & 15u) >> 2, pp = lane & 3u;
    const unsigned r0 = 32u * ks + 8u * g + q;
    const s16x4 a = __builtin_amdgcn_ds_read_tr16_b64_v4i16((LAS s16x4*)(img + offb(r0, 2u * c + (pp >> 1)) + 8u * (pp & 1u)));
    const s16x4 b = __builtin_amdgcn_ds_read_tr16_b64_v4i16((LAS s16x4*)(img + offb(r0 + 4u, 2u * c + (pp >> 1)) + 8u * (pp & 1u)));
    return __builtin_shufflevector(a, b, 0, 1, 2, 3, 4, 5, 6, 7);
}
__device__ void chain_item(const Params& p, int item, bool last, LAS unsigned char* lds) {
    const int tid = tid_l(), w = __builtin_amdgcn_readfirstlane(tid >> 6), lane = tid & 63, fr = lane & 15, fq = lane >> 4;
    const int vh = item & 1, dir = (item >> 1) & 1, h = (item >> 2) & 3, b = item >> 4;
    LAS unsigned char* Qs = lds;
    LAS unsigned char* Kw = lds + 32768;
    LAS unsigned char* Vs = lds + 65536;
    LAS unsigned char* Ct = lds + 98304;
    LAS float* s_a = (LAS float*)(lds + 114688);
    LAS float* s_cm = s_a + 18 * 128;
    LAS float* s_b = s_cm + 18 * 128;
    LAS float* s_nv = s_b + 18 * 128;
    const bf16_t* PB = (const bf16_t*)(p.ws + WS_PBUF); const float* GATES = (const float*)(p.ws + WS_GATES);
    bf16_t* ACT = (bf16_t*)(p.ws + WS_ACT); bf16_t* HB = (bf16_t*)p.out;
#define CHUNK_BASE(s) (dir == 0 ? ((s) < 2 ? RLAT + b * CTXL + 128 * (s) : b * SEQ + 128 * ((s) - 2)) : ((s) < 2 ? RLAT + b * CTXL + 128 * (1 - (s)) : b * SEQ + 128 * (17 - (s))))
#define LOAD_CHUNK(s) do { const int _base = CHUNK_BASE(s); \
        _Pragma("unroll") for (int e = 0; e < 4; ++e) { const int _row = e * 32 + (tid >> 4); const int _tok = _base + (dir ? 127 - _row : _row); \
            const bf16_t* _pr = PB + (size_t)_tok * NP + 128 * h + (tid & 15) * 8; qreg[e] = *(const u32x4*)(_pr + PQ); kreg[e] = *(const u32x4*)(_pr + PK); vreg[e] = *(const u32x4*)(_pr + PV); } } while (0)
    u32x4 qreg[4], kreg[4], vreg[4];
    LOAD_CHUNK(0);
    for (int j = w; j < 18; j += 8) {
        const int cb = CHUNK_BASE(j);
        const int t0 = cb + (dir ? 127 - 2 * lane : 2 * lane), t1 = cb + (dir ? 126 - 2 * lane : 2 * lane + 1);
        const float* g0 = GATES + (size_t)t0 * 16 + dir * 8 + h; const float* g1 = GATES + (size_t)t1 * 16 + dir * 8 + h;
        const float i0 = g0[0], f0 = g0[4], i1 = g1[0], f1 = g1[4];
        const float l0 = fminf(f0, 0.f) - log1pf(expf(-fabsf(f0))), l1 = fminf(f1, 0.f) - log1pf(expf(-fabsf(f1)));
        float incl = l0 + l1;
#pragma unroll
        for (int off = 1; off < 64; off <<= 1) { const float tv = __shfl_up(incl, off); if (lane >= off) incl += tv; }
        const float b1 = incl, b0 = incl - l1;
        const float a0 = i0 - b0, a1 = i1 - b1;
        float mx = fmaxf(a0, a1);
#pragma unroll
        for (int off = 1; off < 64; off <<= 1) { const float tv = __shfl_up(mx, off); if (lane >= off) mx = fmaxf(mx, tv); }
        float ex = __shfl_up(mx, 1); if (lane == 0) ex = -INFINITY;
        s_a[j * 128 + 2 * lane] = a0; s_a[j * 128 + 2 * lane + 1] = a1;
        s_cm[j * 128 + 2 * lane] = fmaxf(ex, a0); s_cm[j * 128 + 2 * lane + 1] = mx;
        s_b[j * 128 + 2 * lane] = b0; s_b[j * 128 + 2 * lane + 1] = b1;
    }
    for (int i = tid; i < 16384 / 4; i += 512) ((LAS unsigned*)Ct)[i] = 0u;
    if (tid < 128) s_nv[tid] = 0.f;
    f32x4 cacc[4], nacc = (f32x4){0.f, 0.f, 0.f, 0.f};
#pragma unroll
    for (int x = 0; x < 4; ++x) cacc[x] = (f32x4){0.f, 0.f, 0.f, 0.f};
    float m_st = 0.f;
    bf16x8 ones;
#pragma unroll
    for (int x = 0; x < 8; ++x) ones[x] = (short)0x3F80;
    __syncthreads();
    const int t = 16 * w + fr;
    const int jt_s = w & 3, it0 = (w >> 2) * 4;
    for (int s = 0; s < 18; ++s) {
        const int base = CHUNK_BASE(s);
        const float c127 = fmaxf(m_st, s_cm[s * 128 + 127]), b127 = s_b[s * 128 + 127];
        const float decay = expf(m_st - c127);
#pragma unroll
        for (int e = 0; e < 4; ++e) { const int row = e * 32 + (tid >> 4), ch = tid & 15; const float wv = expf(s_a[s * 128 + row] - c127); u32x4 o;
#pragma unroll
            for (int x = 0; x < 4; ++x) { const unsigned u = kreg[e][x]; o[x] = cvt_pk_bf16(bflo(u) * wv, bfhi(u) * wv); }
            const unsigned ob = offb(row, ch);
            *(LAS u32x4*)(Qs + ob) = qreg[e]; *(LAS u32x4*)(Kw + ob) = o; *(LAS u32x4*)(Vs + ob) = vreg[e]; }
        if (s + 1 < 18) LOAD_CHUNK(s + 1);
        __syncthreads();
        bf16x8 qa[4];
#pragma unroll
        for (int kk = 0; kk < 4; ++kk) qa[kk] = rd_row(Qs, t, 4 * kk + fq);
        float qn = 0.f;
#pragma unroll
        for (int kk = 0; kk < 4; ++kk) { const f32x4 n0 = *(const LAS f32x4*)(s_nv + 32 * kk + 8 * fq), n1 = *(const LAS f32x4*)(s_nv + 32 * kk + 8 * fq + 4);
            qn += bf2f(qa[kk][0]) * n0[0] + bf2f(qa[kk][1]) * n0[1] + bf2f(qa[kk][2]) * n0[2] + bf2f(qa[kk][3]) * n0[3]
                + bf2f(qa[kk][4]) * n1[0] + bf2f(qa[kk][5]) * n1[1] + bf2f(qa[kk][6]) * n1[2] + bf2f(qa[kk][7]) * n1[3]; }
        qn += __shfl_xor(qn, 16); qn += __shfl_xor(qn, 32);
        float rs = 0.f;
#pragma unroll
        for (int n = 0; n < 8; ++n) { if (n > (w | 1)) continue;
            f32x4 sa = (f32x4){0.f, 0.f, 0.f, 0.f};
#pragma unroll
            for (int kk = 0; kk < 4; ++kk) sa = mfma16(rd_row(Kw, 16 * n + fr, 4 * kk + fq), qa[kk], sa);
#pragma unroll
            for (int r = 0; r < 4; ++r) { const int s_ = 16 * n + 4 * fq + r; sa[r] = (s_ <= t) ? sa[r] : 0.f; rs += sa[r]; }
            u32x2 pk; pk.x = cvt_pk_bf16(sa[0], sa[1]); pk.y = cvt_pk_bf16(sa[2], sa[3]);
            *(LAS u32x2*)(Qs + offb(t, 2 * n + (fq >> 1)) + 8 * (fq & 1)) = pk; }
        rs += __shfl_xor(rs, 16); rs += __shfl_xor(rs, 32);
        f32x4 u1[4], u2[4];
#pragma unroll
        for (int jt = 0; jt < 4; ++jt) { u2[jt] = (f32x4){0.f, 0.f, 0.f, 0.f};
#pragma unroll
            for (int kk = 0; kk < 4; ++kk) u2[jt] = mfma16(rd_row(Ct, 16 * jt + fr, 4 * kk + fq), qa[kk], u2[jt]); }
        { bf16x8 pb[4];
#pragma unroll
            for (int kk = 0; kk < 4; ++kk) pb[kk] = rd_row(Qs, t, 4 * kk + fq);
#pragma unroll
            for (int jt = 0; jt < 4; ++jt) u1[jt] = (f32x4){0.f, 0.f, 0.f, 0.f};
#pragma unroll
            for (int kk = 0; kk < 4; ++kk) { if (kk > (w >> 1)) continue;
#pragma unroll
                for (int jt = 0; jt < 4; ++jt) u1[jt] = mfma16(rd_tr(Vs, lane, 4 * vh + jt, kk), pb[kk], u1[jt]); } }
        if (!(last && s < 2)) {
            const float ct = fmaxf(m_st, s_cm[s * 128 + t]);
            const float gt = expf(c127 - ct), it = expf(m_st - ct), em = expf(-(s_b[s * 128 + t] + ct));
            const float den = gt * rs + it * qn; const float inv = 1.f / fmaxf(fabsf(den), em);
            const int tok = base + (dir ? 127 - t : t);
            bf16_t* dst = (dir == 0 ? ACT + (size_t)tok * D : HB + (size_t)tok * 512) + 128 * h + 64 * vh + 4 * fq;
#pragma unroll
            for (int jt = 0; jt < 4; ++jt) { u32x2 o; o.x = cvt_pk_bf16((gt * u1[jt][0] + it * u2[jt][0]) * inv, (gt * u1[jt][1] + it * u2[jt][1]) * inv);
                o.y = cvt_pk_bf16((gt * u1[jt][2] + it * u2[jt][2]) * inv, (gt * u1[jt][3] + it * u2[jt][3]) * inv);
                *(u32x2*)(dst + 16 * jt) = o; }
        }
#pragma unroll
        for (int x = 0; x < 4; ++x) cacc[x] *= decay;
        nacc *= decay;
#pragma unroll
        for (int kk = 0; kk < 4; ++kk) { const bf16x8 vb = rd_tr(Vs, lane, 4 * vh + jt_s, kk);
#pragma unroll
            for (int x = 0; x < 4; ++x) cacc[x] = mfma16(rd_tr(Kw, lane, it0 + x, kk), vb, cacc[x]);
            nacc = mfma16(rd_tr(Kw, lane, w, kk), ones, nacc); }
        m_st = b127 + c127;
        __syncthreads();
#pragma unroll
        for (int x = 0; x < 4; ++x) { u32x2 o; o.x = cvt_pk_bf16(cacc[x][0], cacc[x][1]); o.y = cvt_pk_bf16(cacc[x][2], cacc[x][3]);
            *(LAS u32x2*)(Ct + offb(16 * jt_s + fr, 2 * (it0 + x) + (fq >> 1)) + 8 * (fq & 1)) = o; }
        if (fr == 0) *(LAS f32x4*)(s_nv + 16 * w + 4 * fq) = nacc;
    }
    __syncthreads();
#undef LOAD_CHUNK
#undef CHUNK_BASE
}

__device__ void gmlp_item(const Params& p, int l, int ch, LAS unsigned char* lds) {
    const int tid = tid_l(), w = tid >> 6, lane = tid & 63, fr = lane & 15, fq = lane >> 4;
    const bf16_t* PB = (const bf16_t*)(p.ws + WS_PBUF); bf16_t* ACT = (bf16_t*)(p.ws + WS_ACT);
    const int row0 = ch * 128;
    { const int c8 = (tid & 31) * 8; const float* gn = p.in[12] + l * 256 + c8;
        const f32x4 g0 = *(const f32x4*)gn, g1 = *(const f32x4*)(gn + 4);
        u32x4 vv[8];
#pragma unroll
        for (int ps = 0; ps < 8; ++ps) vv[ps] = *(const u32x4*)(PB + (size_t)(row0 + ps * 16 + (tid >> 5)) * NP + PGV + c8);
#pragma unroll
        for (int ps = 0; ps < 8; ++ps) { const int s = ps * 16 + (tid >> 5);
            const u32x4 v = vv[ps];
            float f[8]; f[0] = bflo(v.x); f[1] = bfhi(v.x); f[2] = bflo(v.y); f[3] = bfhi(v.y); f[4] = bflo(v.z); f[5] = bfhi(v.z); f[6] = bflo(v.w); f[7] = bfhi(v.w);
            float ss = 0.f;
#pragma unroll
            for (int x = 0; x < 8; ++x) ss += f[x] * f[x];
#pragma unroll
            for (int o = 16; o >= 1; o >>= 1) ss += __shfl_xor(ss, o);
            const float rstd = rsqrtf(ss * (1.f / 256.f) + EPS);
            u32x4 o; o.x = cvt_pk_bf16(f[0] * rstd * g0[0], f[1] * rstd * g0[1]); o.y = cvt_pk_bf16(f[2] * rstd * g0[2], f[3] * rstd * g0[3]);
            o.z = cvt_pk_bf16(f[4] * rstd * g1[0], f[5] * rstd * g1[1]); o.w = cvt_pk_bf16(f[6] * rstd * g1[2], f[7] * rstd * g1[3]);
            *(LAS u32x4*)(lds + 32768 * ((tid & 31) >> 4) + offb(s, tid & 15)) = o; } }
    __syncthreads();
    const int t = 16 * w + fr;
    const size_t grow = (size_t)(row0 + t);
#pragma unroll 1
    for (int g = 0; g < 4; ++g) {
        const float* wsr = p.in[13] + (((size_t)l * 4 + g) * 128 + t) * 128;
        bf16x8 wb[4];
#pragma unroll
        for (int kk = 0; kk < 4; ++kk) { const f32x4 a = *(const f32x4*)(wsr + 32 * kk + 8 * fq), c = *(const f32x4*)(wsr + 32 * kk + 8 * fq + 4);
            u32x4 o; o.x = cvt_pk_bf16(a[0], a[1]); o.y = cvt_pk_bf16(a[2], a[3]); o.z = cvt_pk_bf16(c[0], c[1]); o.w = cvt_pk_bf16(c[2], c[3]);
            wb[kk] = __builtin_bit_cast(bf16x8, o); }
        const float bs = p.in[14][((size_t)l * 4 + g) * 128 + t];
        const LAS unsigned char* img = lds + 32768 * (g >> 1);
#pragma unroll
        for (int cc = 0; cc < 4; ++cc) { const int ct = 4 * g + cc; f32x4 acc = (f32x4){0.f, 0.f, 0.f, 0.f};
#pragma unroll
            for (int kk = 0; kk < 4; ++kk) acc = mfma16(rd_tr(img, lane, ct & 7, kk), wb[kk], acc);
            const int c = 16 * ct + 4 * fq;
            const u32x2 uu = *(const u32x2*)(PB + grow * NP + PGU + c);
            u32x2 o; o.x = cvt_pk_bf16(bflo(uu.x) * (acc[0] + bs), bfhi(uu.x) * (acc[1] + bs)); o.y = cvt_pk_bf16(bflo(uu.y) * (acc[2] + bs), bfhi(uu.y) * (acc[3] + bs));
            *(u32x2*)(ACT + grow * D + 768 + c) = o; }
    }
    __syncthreads();
}

__device__ void conv_all(const Params& p, int l, int nrows) {
    const bf16_t* PB = (const bf16_t*)(p.ws + WS_PBUF); bf16_t* ACT = (bf16_t*)(p.ws + WS_ACT);
    const float* cw = p.in[11] + (size_t)l * 3 * 256;
    for (int idx = bid_l() * 512 + tid_l(); idx < nrows * 32; idx += gridDim.x * 512) {
        const int row = idx >> 5, c8 = (idx & 31) * 8;
        bool hp, hn;
        if (row < RLAT) { const int pos = row & 63; hp = pos > 0; hn = pos < 63; } else { const int pos = (row - RLAT) & 255; hp = pos > 0; hn = pos < 255; }
        const bf16_t* pr = PB + (size_t)row * NP + c8;
        const u32x4 gb = *(const u32x4*)(pr + PCB);
        const u32x4 c1 = *(const u32x4*)(pr + PCC), h1 = *(const u32x4*)(pr + PCH);
        u32x4 c0 = (u32x4){0u, 0u, 0u, 0u}, h0 = c0, c2 = c0, h2 = c0;
        if (hp) { c0 = *(const u32x4*)(pr - NP + PCC); h0 = *(const u32x4*)(pr - NP + PCH); }
        if (hn) { c2 = *(const u32x4*)(pr + NP + PCC); h2 = *(const u32x4*)(pr + NP + PCH); }
        u32x4 o;
#pragma unroll
        for (int x = 0; x < 4; ++x) {
            const int c = c8 + 2 * x;
            const float ylo = cw[c] * (bflo(c0[x]) * bflo(h0[x])) + cw[256 + c] * (bflo(c1[x]) * bflo(h1[x])) + cw[512 + c] * (bflo(c2[x]) * bflo(h2[x]));
            const float yhi = cw[c + 1] * (bfhi(c0[x]) * bfhi(h0[x])) + cw[256 + c + 1] * (bfhi(c1[x]) * bfhi(h1[x])) + cw[512 + c + 1] * (bfhi(c2[x]) * bfhi(h2[x]));
            o[x] = cvt_pk_bf16(bflo(gb[x]) * ylo, bfhi(gb[x]) * yhi);
        }
        *(u32x4*)(ACT + (size_t)row * D + 512 + c8) = o;
    }
}

__device__ void combine_all(const Params& p, int l, int nrows) {
    const bf16_t* PB = (const bf16_t*)(p.ws + WS_PBUF); bf16_t* ACT = (bf16_t*)(p.ws + WS_ACT); const bf16_t* HB = (const bf16_t*)p.out;
    const float* mn = p.in[10] + (size_t)l * 512;
    for (int idx = bid_l() * 512 + tid_l(); idx < nrows * 64; idx += gridDim.x * 512) {
        const int row = idx >> 6, c8 = (idx & 63) * 8;
        const u32x4 a = *(const u32x4*)(ACT + (size_t)row * D + c8), bb = *(const u32x4*)(HB + (size_t)row * 512 + c8), og = *(const u32x4*)(PB + (size_t)row * NP + PO + c8);
        float f[8]; float ss = 0.f;
#pragma unroll
        for (int x = 0; x < 4; ++x) { f[2 * x] = bflo(a[x]) + bflo(bb[x]); f[2 * x + 1] = bfhi(a[x]) + bfhi(bb[x]); ss += f[2 * x] * f[2 * x] + f[2 * x + 1] * f[2 * x + 1]; }
#pragma unroll
        for (int o = 8; o >= 1; o >>= 1) ss += __shfl_xor(ss, o);
        const float rstd = rsqrtf(ss * (1.f / 128.f) + EPS);
        u32x4 o;
#pragma unroll
        for (int x = 0; x < 4; ++x) {
            const float o0 = 1.f / (1.f + __expf(-bflo(og[x]))), o1 = 1.f / (1.f + __expf(-bfhi(og[x])));
            o[x] = cvt_pk_bf16(o0 * f[2 * x] * rstd * mn[c8 + 2 * x], o1 * f[2 * x + 1] * rstd * mn[c8 + 2 * x + 1]);
        }
        *(u32x4*)(ACT + (size_t)row * D + c8) = o;
    }
}

#include <cstdio>
#include <cstdint>
#include <cstdlib>
#include <vector>

#define XB_TMO      128
#define XB_XCNT(j)  (256  + 64 * (j))
#define XB_XSUB(j)  (1280 + 64 * (j))
#define XB_XGEN(j)  (2304 + 64 * (j))
#define XB_TOP      3328
#define XB_TOPGEN   3392
#define XCD_BAR_WORDS 3456
#define XB_SPIN_CAP (1u << 18)

__device__ __forceinline__ unsigned xb_ld(unsigned* p)              { return __hip_atomic_load(p, __ATOMIC_RELAXED, __HIP_MEMORY_SCOPE_AGENT); }
__device__ __forceinline__ unsigned xb_add(unsigned* p, unsigned v) { return __hip_atomic_fetch_add(p, v, __ATOMIC_RELAXED, __HIP_MEMORY_SCOPE_AGENT); }
__device__ __forceinline__ unsigned xb_xcc_id() { return (unsigned)__builtin_amdgcn_s_getreg((3 << 11) | 20) & 0xFu; }
#define XB_SPIN(cond, bar) do { unsigned _sp = 0; while (cond) { __builtin_amdgcn_s_sleep(1); \
    if ((++_sp & 255u) == 0u) { if (xb_ld(&(bar)[XB_TMO])) break; if (_sp > XB_SPIN_CAP) { atomicAdd(&(bar)[XB_TMO], 1u); break; } } } } while (0)

struct XcdBarrier {
    unsigned* bar; unsigned x;
    volatile LAS unsigned* st;
};

__device__ __forceinline__ XcdBarrier xcd_barrier_post(unsigned* bar, volatile LAS unsigned* st) {
    XcdBarrier b; b.bar = bar; b.x = xb_xcc_id(); b.st = st;
    if (threadIdx.x == 0) (void)xb_add(&bar[XB_XCNT(b.x)], 1u);
    return b;
}
__device__ __forceinline__ void xcd_barrier_complete(unsigned* bar, unsigned x, unsigned& nloc, unsigned& nx) {
    const unsigned G = gridDim.x * gridDim.y * gridDim.z;
    unsigned sum, cnt, mine, sp = 0u;
    for (;;) {
        sum = 0u; cnt = 0u; mine = 0u;
#pragma unroll
        for (unsigned j = 0; j < 16; ++j) { const unsigned c = xb_ld(&bar[XB_XCNT(j)]); sum += c; cnt += (c > 0u) ? 1u : 0u; mine = (j == x) ? c : mine; }
        if (sum == G) break;
        __builtin_amdgcn_s_sleep(1);
        if ((++sp & 255u) == 0u) { if (xb_ld(&bar[XB_TMO])) break; if (sp > XB_SPIN_CAP) { atomicAdd(&bar[XB_TMO], 1u); break; } }
    }
    nloc = mine > 0u ? mine : 1u; nx = cnt > 0u ? cnt : 1u;
}

__device__ __forceinline__ void xcd_barrier(const XcdBarrier& b) {
    asm volatile("s_waitcnt vmcnt(0)" ::: "memory");
    __syncthreads();
    if (threadIdx.x == 0) {
        unsigned* bar = b.bar;
        __builtin_amdgcn_s_waitcnt(0);
        unsigned nloc = b.st[0], nx = b.st[1];
        if (nloc == 0u) { xcd_barrier_complete(bar, b.x, nloc, nx); b.st[0] = nloc; b.st[1] = nx; }
        const unsigned old = xb_add(&bar[XB_XSUB(b.x)], 1u);
        const unsigned gen = old / nloc;
        if (old + 1u == (gen + 1u) * nloc) {
            __builtin_amdgcn_fence(__ATOMIC_RELEASE, "agent");
            asm volatile("s_waitcnt vmcnt(0)" ::: "memory");
            const unsigned og = xb_add(&bar[XB_TOP], 1u);
            const unsigned tg = og / nx;
            if (og + 1u == (tg + 1u) * nx) xb_add(&bar[XB_TOPGEN], 1u);
            else XB_SPIN(xb_ld(&bar[XB_TOPGEN]) == tg, bar);
            __builtin_amdgcn_fence(__ATOMIC_ACQUIRE, "agent");
            xb_add(&bar[XB_XGEN(b.x)], 1u);
            asm volatile("s_waitcnt vmcnt(0)" ::: "memory");
        } else {
            XB_SPIN(xb_ld(&bar[XB_XGEN(b.x)]) == gen, bar);
            __builtin_amdgcn_fence(__ATOMIC_ACQUIRE, "agent");
            asm volatile("s_waitcnt vmcnt(0)" ::: "memory");
        }
    }
    __syncthreads();
}


__device__ __forceinline__ void run_phase(const Params& p, int ph, LAS unsigned char* lds, bool prep = false) {
    if (ph == 0) { phase_prep(p, lds); return; }
    if (ph == NPHASE - 1) { phase_norm<2>(p, 0, RLAT, false, lds); return; }
    const int l = (ph - 1) >> 3, sub = (ph - 1) & 7; const bool last = (l == DEPTH - 1);
    const int nrows = last ? RLAT : ROWS;
    bf16_t* ACT = (bf16_t*)(p.ws + WS_ACT); bf16_t* PBUF = (bf16_t*)(p.ws + WS_PBUF);
    const bf16_t* WB = (const bf16_t*)(p.ws + WS_WB) + (size_t)l * WL_SZ;
    pg8::StaticOrder S;
    if (sub == 0) { phase_norm<0>(p, l, ROWS, l > 0, lds); }
    else if (sub == 1) { pg8::Gemm g; g.A = ACT; g.Bt = WB + WL_IN; g.M = ROWS; g.N = NP; g.K = D; S.init(g.M, g.N, (int)gridDim.x, (int)bid_l()); S.ntk = g.K / 64;
        EpiP E; E.O = PBUF; E.ldc = NP; pg8::gemm_phase<EpiP, pg8::StaticOrder, false>(lds, g, S, E, nullptr); }
    else if (sub == 2) {
        for (int rep = 0; rep < ((PROBE >> 9) & 1) + 1; ++rep)
        for (int item = bid_l(); item < 256; item += gridDim.x) chain_item(p, item, last, lds);
        for (int rep = 0; rep < ((PROBE >> 10) & 1) + 1; ++rep) {
        for (int ch = bid_l(); ch < nrows / 128; ch += gridDim.x) gmlp_item(p, l, ch, lds);
        conv_all(p, l, nrows); }
    }
    else if (sub == 3) { combine_all(p, l, nrows); }
    else if (sub == 4 || sub == 7) { pg8::Gemm g; g.M = RLAT; g.N = D;
        if (sub == 4) { g.A = ACT; g.Bt = WB + WL_OUT; g.K = D; } else { g.A = PBUF; g.Bt = WB + WL_2; g.K = DFF; }
        S.init(g.M, g.N, (int)gridDim.x, (int)bid_l()); S.ntk = g.K / 64;
        EpiResid E; E.xb = (bf16_t*)(p.ws + WS_XB); E.modl = (const float*)(p.ws + WS_MOD) + (size_t)l * 17 * 6144; E.goff = sub == 4 ? 2048 : 5120; E.gscale = prep ? 0.f : 1.f;
        pg8::gemm_phase<EpiResid, pg8::StaticOrder, false>(lds, g, S, E, nullptr);
        if (!last && !prep) {
            SplitOrder S2; S2.G = (int)gridDim.x; S2.c = (int)bid_l(); S2.ntk = g.K / 64;
            EpiPartial E2; E2.scr = (float*)((unsigned char*)p.out + OUT_SCR); E2.modl = E.modl; E2.goff = E.goff;
            pg8::gemm_phase<EpiPartial, SplitOrder, false>(lds, g, S2, E2, nullptr); } }
    else if (sub == 5) { phase_norm<1>(p, l, nrows, !last, lds); }
    else { pg8::Gemm g; g.A = ACT; g.Bt = WB + WL_13; g.M = nrows; g.N = 2 * DFF; g.K = D; S.init(g.M, g.N, (int)gridDim.x, (int)bid_l()); S.ntk = g.K / 64;
        EpiSwiglu E; E.O = PBUF; pg8::gemm_phase<EpiSwiglu, pg8::StaticOrder, false>(lds, g, S, E, nullptr); }
}

__global__ void __launch_bounds__(512, 2) fwd_kernel(Params p, int ph_lo, int ph_hi) {
    extern __shared__ __attribute__((aligned(16))) unsigned char shm[];
    LAS unsigned char* lds = (LAS unsigned char*)shm;
    cg::grid_group grid = cg::this_grid();
    volatile LAS unsigned* st = (volatile LAS unsigned*)(lds + LDS_BYTES - 16);
    if (threadIdx.x == 0) { st[0] = 0u; st[1] = 0u; }
    __syncthreads();
    const XcdBarrier xb = xcd_barrier_post((unsigned*)(p.ws + WS_BAR), st);
    for (int ph = ph_lo; ph < ph_hi; ++ph) {
        run_phase(p, ph, lds);
        if (PROBE) { const int sub = (ph - 1) & 7; const bool rep = (ph == 0) ? ((PROBE >> 8) & 1) : (ph < NPHASE - 1 && ((PROBE >> sub) & 1));
            if (rep) { if (ph == 0) grid.sync(); else xcd_barrier(xb); run_phase(p, ph, lds, true); } }
        if (ph + 1 < ph_hi) { if (ph == ph_lo) grid.sync(); else xcd_barrier(xb); }
    }
}

extern "C" void kernel_launch(void* const* d_in, const int* in_sizes, int n_in, void* d_out, int out_size, void* d_ws, size_t ws_size, hipStream_t stream) {
    static int grid = 0;
    if (grid == 0) {
        if (n_in != 20 || out_size != RLAT * D || ws_size < WS_END) { fprintf(stderr, "kernel_launch: unexpected shapes (n_in %d, out %d, ws %zu, need %zu)\n", n_in, out_size, ws_size, (size_t)WS_END); grid = -1; return; }
        int dev = 0, cus = 0, per_cu = 0;
        (void)hipGetDevice(&dev); (void)hipDeviceGetAttribute(&cus, hipDeviceAttributeMultiprocessorCount, dev);
        if (hipFuncSetAttribute((const void*)fwd_kernel, hipFuncAttributeMaxDynamicSharedMemorySize, LDS_BYTES) != hipSuccess) { fprintf(stderr, "kernel_launch: hipFuncSetAttribute failed\n"); grid = -1; return; }
        if (hipOccupancyMaxActiveBlocksPerMultiprocessor(&per_cu, (const void*)fwd_kernel, 512, LDS_BYTES) != hipSuccess || per_cu < 1) { fprintf(stderr, "kernel_launch: occupancy query failed (%d)\n", per_cu); (void)hipGetLastError(); per_cu = 1; }
        grid = cus * per_cu;
    }
    if (grid < 0) return;
    if (hipMemsetAsync((char*)d_ws + WS_BAR, 0, 16384, stream) != hipSuccess) { fprintf(stderr, "kernel_launch: memset of barrier words failed\n"); return; }
    Params p{};
    for (int i = 0; i < 20; ++i) p.in[i] = (const float*)d_in[i];
    p.out = (float*)d_out; p.ws = (unsigned char*)d_ws;
    int lo = 0, hi = NPHASE;
    void* args[] = {&p, &lo, &hi};
    hipError_t e = hipLaunchCooperativeKernel((const void*)fwd_kernel, dim3(grid), dim3(512), args, LDS_BYTES, stream);
    if (e != hipSuccess) fprintf(stderr, "kernel_launch: cooperative launch failed: %s (grid %d)\n", hipGetErrorString(e), grid);
}
```

```cpp
#include <hip/hip_runtime.h>
#include <hip/hip_cooperative_groups.h>
#include <cstdio>
namespace cg = cooperative_groups;
__device__ __forceinline__ int tid_l() { int t = threadIdx.x; asm volatile("" : "+v"(t)); return t; }
__device__ __forceinline__ int bid_l() { int t = blockIdx.x; asm volatile("" : "+s"(t)); return t; }
namespace pg8 {
#define PG8_LAS __attribute__((address_space(3)))
typedef unsigned short bf16_t;
typedef short bf16x8 __attribute__((ext_vector_type(8)));
typedef float f32x4 __attribute__((ext_vector_type(4)));
typedef unsigned u32x4 __attribute__((ext_vector_type(4)));
constexpr int BM = 256, BK = 64, HALF = 128, HTB = HALF * BK * 2  , STAGE_BYTES = 8 * HTB, NXCD = 8, WGM = 8;

__host__ __device__ __forceinline__ int lds_byte(int r, int c) { const int st = (r >> 4) * 2 + (c >> 5), rr = r & 15, cc = c & 31, ob = rr * 64 + cc * 2; return st * 1024 + (ob ^ (((ob >> 9) & 1) << 5)); }
__host__ __device__ __forceinline__ void stage_rc(int b, int& R, int& C) { const int st = b / 1024, sb = b % 1024, swz = sb ^ (((sb >> 9) & 1) << 5); R = (st >> 1) * 16 + swz / 64; C = (st & 1) * 32 + (swz % 64) / 2; }
__host__ __device__ __forceinline__ int perm32(int rho) { const int n = rho >> 4, i = rho & 15; return 8 * (i >> 2) + 4 * n + (i & 3); }

struct Unit { int pm, pn, k0, nt; };
struct Gemm { const bf16_t* A; const bf16_t* Bt; int M, N, K; };

struct StaticOrder {
    int nM, nN, nwg, G, c, ntk;
    __host__ __device__ void init(int M, int N, int G_, int c_) { nM = M / BM; nN = N / BM; nwg = nM * nN; G = G_; c = c_; }
    __host__ __device__ bool next(int i, Unit& u) const {
        const long L = (long)i * G + c; if (L >= nwg) return false;
        int wgid = (int)L; { const int q = nwg / NXCD, r = nwg % NXCD, xcd = wgid % NXCD, off = wgid / NXCD; wgid = (xcd < r ? xcd * (q + 1) : r * (q + 1) + (xcd - r) * q) + off; }
        const int nig = WGM * nN, gid = wgid / nig, fm = gid * WGM, gsz = (nM - fm) < WGM ? (nM - fm) : WGM;
        u.pm = fm + ((wgid % nig) % gsz); u.pn = (wgid % nig) / gsz; u.k0 = 0; u.nt = ntk; return true;
    }
    __device__ __forceinline__ void a_ready(const Unit&) const {}
    __device__ __forceinline__ void done(const Unit&) const {}
};
__device__ __forceinline__ unsigned cvt_pk_bf16(float lo, float hi) { unsigned r; asm volatile("v_cvt_pk_bf16_f32 %0, %1, %2" : "=v"(r) : "v"(lo), "v"(hi)); return r; }
template <class Epi, class Sched, bool STAMP = false>
__device__ __forceinline__ void gemm_phase(PG8_LAS unsigned char* lds, const Gemm g, const Sched& S, const Epi& E, unsigned long long* stamps) {
    const int tid = tid_l(), wid = __builtin_amdgcn_readfirstlane(tid >> 6), lane = tid & 63, wr = wid >> 2, wc = wid & 3, fr = lane & 15, fq = lane >> 4;
    const int K = g.K;
    int ts_lo = 0, ts_hi = 0, nts = 0; const unsigned long long rt_entry = STAMP ? (unsigned long long)wall_clock64() : 0ull;
#define PG8_STAMP() do { if (STAMP && wid == 0 && nts < 64) { const unsigned long long _c = (unsigned long long)clock64(); \
        ts_lo = (lane == nts) ? (int)(unsigned)_c : ts_lo; ts_hi = (lane == nts) ? (int)(unsigned)(_c >> 32) : ts_hi; ++nts; } } while (0)
    PG8_STAMP();
    unsigned voffA[2], voffB[2];
#pragma unroll
    for (int i = 0; i < 2; ++i) { int R, C; stage_rc(tid * 16 + i * 8192, R, C); const int Rb = Epi::PERM ? ((R & ~31) + perm32(R & 31)) : R;
        voffA[i] = (unsigned)(R * K + C) * 2u; voffB[i] = (unsigned)(Rb * K + C) * 2u; }
    const size_t kstep = (size_t)(BK * 2);
    const size_t hstep = (size_t)HALF * K * 2;
    const size_t tstep = 2 * hstep;
    const unsigned ldsw = (unsigned)wid * 1024u;
    const int aoff = lds_byte(wr * 64 + fr, fq * 8), boff = lds_byte(wc * 32 + fr, fq * 8);
#define PG8_SA(b, h) (((b) * 2 + (h)) * HTB)
#define PG8_SB(b, h) ((4 + (b) * 2 + (h)) * HTB)
#define PG8_STAGE(bufoff, gbase, voff) do { _Pragma("unroll") for (int _i = 0; _i < 2; ++_i) \
        __builtin_amdgcn_global_load_lds((const unsigned*)((const char*)(gbase) + (voff)[_i]), (PG8_LAS unsigned*)(lds + (bufoff) + ldsw + _i * 8192), 16, 0, 0); } while (0)
#define PG8_LDA(dst, b, h) do { _Pragma("unroll") for (int m = 0; m < 4; ++m) _Pragma("unroll") for (int k = 0; k < 2; ++k) dst[m][k] = *(const PG8_LAS bf16x8*)(lds + PG8_SA(b, h) + aoff + m * 2048 + k * 1024); } while (0)
#define PG8_LDB(dst, b, h) do { _Pragma("unroll") for (int n = 0; n < 2; ++n) _Pragma("unroll") for (int k = 0; k < 2; ++k) dst[n][k] = *(const PG8_LAS bf16x8*)(lds + PG8_SB(b, h) + boff + n * 2048 + k * 1024); } while (0)
#define PG8_MMA(ai, bj, At, Bt) do { __builtin_amdgcn_s_setprio(1); _Pragma("unroll") for (int m = 0; m < 4; ++m) _Pragma("unroll") for (int n = 0; n < 2; ++n) _Pragma("unroll") for (int k = 0; k < 2; ++k) \
        acc[ai][bj][m][n] = __builtin_amdgcn_mfma_f32_16x16x32_bf16(Bt[n][k], At[m][k], acc[ai][bj][m][n], 0, 0, 0); __builtin_amdgcn_s_setprio(0); } while (0)
#define PG8_WAIT_V(n) asm volatile("s_waitcnt vmcnt(" #n ")" ::: "memory")
#define PG8_WAIT_L(n) asm volatile("s_waitcnt lgkmcnt(" #n ")" ::: "memory")
#define PG8_BAR __builtin_amdgcn_s_barrier()
#define PG8_SCHED __builtin_amdgcn_sched_barrier(0)
    Unit cur, nxt; int ui = 0;
    if (!S.next(0, cur)) return;
    f32x4 acc[2][2][4][2];
#pragma unroll
    for (int a = 0; a < 2; ++a)
#pragma unroll
        for (int b = 0; b < 2; ++b)
#pragma unroll
            for (int m = 0; m < 4; ++m)
#pragma unroll
                for (int n = 0; n < 2; ++n) acc[a][b][m][n] = (f32x4){0.f, 0.f, 0.f, 0.f};
    bf16x8 At[4][2], B0[2][2], B1[2][2];
    const char* cA = (const char*)g.A + (size_t)cur.pm * tstep + (size_t)cur.k0 * kstep; const char* cB = (const char*)g.Bt + (size_t)cur.pn * tstep + (size_t)cur.k0 * kstep;
    S.a_ready(cur);
    PG8_STAGE(PG8_SB(0, 0), cB, voffB); PG8_STAGE(PG8_SA(0, 0), cA, voffA); PG8_STAGE(PG8_SB(0, 1), cB + hstep, voffB); PG8_STAGE(PG8_SA(0, 1), cA + hstep, voffA);
    if (wr == 1) PG8_BAR;
    PG8_WAIT_V(4); PG8_BAR;
    PG8_STAGE(PG8_SB(1, 0), cB + kstep, voffB); PG8_STAGE(PG8_SA(1, 0), cA + kstep, voffA); PG8_STAGE(PG8_SB(1, 1), cB + hstep + kstep, voffB);
    PG8_WAIT_V(6); PG8_BAR;
    PG8_STAMP();
    for (;;) {
        const bool has_next = S.next(ui + 1, nxt);
        const char* nA = has_next ? (const char*)g.A + (size_t)nxt.pm * tstep + (size_t)nxt.k0 * kstep : cA; const char* nB = has_next ? (const char*)g.Bt + (size_t)nxt.pn * tstep + (size_t)nxt.k0 * kstep : cB;
        const int nt = cur.nt;
        for (int t = 0; t < nt; t += 2) {
            const bool last = (t == nt - 2);
            const char* a1 = cA + (size_t)(t + 1) * kstep;
            const char* a2 = last ? nA : cA + (size_t)(t + 2) * kstep; const char* b2 = last ? nB : cB + (size_t)(t + 2) * kstep;
            const char* a3 = a2 + kstep; const char* b3 = b2 + kstep;
            if (last && has_next) S.a_ready(nxt);
            PG8_LDB(B0, 0, 0); PG8_SCHED; PG8_LDA(At, 0, 0); PG8_STAGE(PG8_SA(1, 1), a1 + hstep, voffA);
            PG8_WAIT_L(8); PG8_BAR; PG8_WAIT_L(0); PG8_MMA(0, 0, At, B0); PG8_BAR; PG8_SCHED;
            PG8_LDB(B1, 0, 1); PG8_STAGE(PG8_SB(0, 0), b2, voffB);
            PG8_BAR; PG8_WAIT_L(0); PG8_MMA(0, 1, At, B1); PG8_BAR;
            PG8_LDA(At, 0, 1); PG8_STAGE(PG8_SA(0, 0), a2, voffA);
            PG8_BAR; PG8_WAIT_L(0); PG8_MMA(1, 0, At, B0); PG8_BAR; PG8_SCHED;
            PG8_STAGE(PG8_SB(0, 1), b2 + hstep, voffB);
            PG8_WAIT_V(6); PG8_BAR; PG8_MMA(1, 1, At, B1); PG8_BAR;
            PG8_LDB(B0, 1, 0); PG8_SCHED; PG8_LDA(At, 1, 0); PG8_STAGE(PG8_SA(0, 1), a2 + hstep, voffA);
            PG8_WAIT_L(8); PG8_BAR; PG8_WAIT_L(0); PG8_MMA(0, 0, At, B0); PG8_BAR; PG8_SCHED;
            PG8_LDB(B1, 1, 1); PG8_STAGE(PG8_SB(1, 0), b3, voffB);
            PG8_BAR; PG8_WAIT_L(0); PG8_MMA(0, 1, At, B1); PG8_BAR;
            PG8_LDA(At, 1, 1); PG8_STAGE(PG8_SA(1, 0), a3, voffA);
            PG8_BAR; PG8_WAIT_L(0); PG8_MMA(1, 0, At, B0); PG8_BAR; PG8_SCHED;
            PG8_STAGE(PG8_SB(1, 1), b3 + hstep, voffB);
            PG8_WAIT_V(6); PG8_BAR; PG8_MMA(1, 1, At, B1); PG8_BAR;
        }
        PG8_STAMP();
        if constexpr (!Epi::AFTER_DRAIN) { E(acc, cur, wr, wc, fr, fq); S.done(cur); }
        PG8_STAMP();
        if (!has_next) break;
#pragma unroll
        for (int a = 0; a < 2; ++a)
#pragma unroll
            for (int b = 0; b < 2; ++b)
#pragma unroll
                for (int m = 0; m < 4; ++m)
#pragma unroll
                    for (int n = 0; n < 2; ++n) acc[a][b][m][n] = (f32x4){0.f, 0.f, 0.f, 0.f};
        cur = nxt; cA = nA; cB = nB; ++ui;
    }
    PG8_WAIT_V(0);
    if (wr == 0) PG8_BAR;
    PG8_BAR;
    if constexpr (Epi::AFTER_DRAIN) { E.fused(acc, cur, wr, wc, fr, fq, lds, wid, lane); S.done(cur); }
    PG8_STAMP();
    if (STAMP && wid == 0) { stamps[lane] = lane < nts ? (((unsigned long long)(unsigned)ts_hi << 32) | (unsigned)ts_lo) : 0ull;
        if (lane == 62) stamps[62] = rt_entry; if (lane == 63) stamps[63] = (unsigned long long)wall_clock64(); }
#undef PG8_STAMP
#undef PG8_SA
#undef PG8_SB
#undef PG8_STAGE
#undef PG8_LDA
#undef PG8_LDB
#undef PG8_MMA
#undef PG8_WAIT_V
#undef PG8_WAIT_L
#undef PG8_BAR
#undef PG8_SCHED
}
}

using pg8::bf16_t; using pg8::bf16x8; using pg8::f32x4; using pg8::u32x4; using pg8::cvt_pk_bf16; using pg8::Unit;
#define LAS __attribute__((address_space(3)))
typedef unsigned u32x2 __attribute__((ext_vector_type(2)));

constexpr int D = 1024, NBATCH = 16, SEQ = 2048, CTXL = 256, DEPTH = 4, DIN = 3344, NP = 3328, NPB = 3584, DFF = 2816;
constexpr int TJ_IN = NPB / 64 * 16, TJ_OUT = TJ_IN + 256, TJ_13 = TJ_OUT + 1408, TJ_ALL = TJ_13 + 704;
constexpr int RLAT = NBATCH * SEQ, RCTX = NBATCH * CTXL, ROWS = RLAT + RCTX;
constexpr int PK = 0, PV = 512, PQ = 1024, PO = 1536, PCB = 2048, PCC = 2304, PCH = 2560, PGU = 2816, PGV = 3072;
constexpr float EPS = 1e-6f;
constexpr int LDS_BYTES = 147456;
#ifndef PROBE
#define PROBE 0
#endif
constexpr int NPHASE = 2 + 8 * DEPTH;
constexpr size_t WS_XB = 0;
constexpr size_t WS_ACT = WS_XB + (size_t)ROWS * D * 2;
constexpr size_t WS_PBUF = WS_ACT + (size_t)ROWS * D * 2;
constexpr size_t WS_GATES = WS_PBUF + (size_t)ROWS * NP * 2;
constexpr size_t OUT_SCR = (size_t)ROWS * 512 * 2;
constexpr size_t WS_MOD = WS_GATES + (size_t)ROWS * 16 * 4;
constexpr size_t WS_WB = WS_MOD + (size_t)DEPTH * 17 * 6144 * 4;
constexpr size_t WL_IN = 0, WL_OUT = (size_t)NPB * D, WL_13 = WL_OUT + (size_t)D * D, WL_2 = WL_13 + (size_t)2 * DFF * D, WL_SZ = WL_2 + (size_t)D * DFF;
constexpr size_t WS_BAR = WS_WB + (size_t)DEPTH * WL_SZ * 2;
constexpr size_t WS_END = WS_BAR + 16384;

struct Params { const float* in[20]; float* out; unsigned char* ws; };

__device__ __forceinline__ float bflo(unsigned u) { return __uint_as_float(u << 16); }
__device__ __forceinline__ float bfhi(unsigned u) { return __uint_as_float(u & 0xffff0000u); }
__device__ __forceinline__ float bf2f(short v) { return __uint_as_float(((unsigned)(unsigned short)v) << 16); }
__device__ __forceinline__ f32x4 mfma16(bf16x8 a, bf16x8 b, f32x4 c) { return __builtin_amdgcn_mfma_f32_16x16x32_bf16(a, b, c, 0, 0, 0); }
__device__ __forceinline__ float silu_f(float a) { return a * __builtin_amdgcn_rcpf(1.f + __expf(-a)); }

struct EpiP {
    static constexpr bool PERM = true, AFTER_DRAIN = false;
    bf16_t* O; int ldc; float* gates; const float* bg;
    __device__ __forceinline__ void operator()(const f32x4 (&acc)[2][2][4][2], const Unit& u, int wr, int wc, int fr, int fq) const {
        const int row0 = u.pm * 256 + wr * 64 + fr, col0 = u.pn * 256 + wc * 32 + 8 * fq;
        if (u.pn == 13) {
            if (wc == 0 && fq < 2) { const f32x4 b0 = *(const f32x4*)(bg + 8 * fq), b1 = *(const f32x4*)(bg + 8 * fq + 4);
#pragma unroll
                for (int ai = 0; ai < 2; ++ai)
#pragma unroll
                    for (int m = 0; m < 4; ++m) { float* gp = gates + (size_t)(row0 + ai * 128 + m * 16) * 16 + 8 * fq;
                        *(f32x4*)gp = acc[ai][0][m][0] + b0; *(f32x4*)(gp + 4) = acc[ai][0][m][1] + b1; } }
            return;
        }
#pragma unroll
        for (int ai = 0; ai < 2; ++ai)
#pragma unroll
            for (int m = 0; m < 4; ++m) { bf16_t* rowp = O + (size_t)(row0 + ai * 128 + m * 16) * ldc + col0;
#pragma unroll
                for (int bj = 0; bj < 2; ++bj) { const f32x4 v0 = acc[ai][bj][m][0], v1 = acc[ai][bj][m][1];
                    u32x4 w; w.x = cvt_pk_bf16(v0[0], v0[1]); w.y = cvt_pk_bf16(v0[2], v0[3]); w.z = cvt_pk_bf16(v1[0], v1[1]); w.w = cvt_pk_bf16(v1[2], v1[3]);
                    *(u32x4*)(rowp + bj * 128) = w; } }
    }
};
struct EpiSwiglu {
    static constexpr bool PERM = true, AFTER_DRAIN = false;
    bf16_t* O;
    __device__ __forceinline__ void operator()(const f32x4 (&acc)[2][2][4][2], const Unit& u, int wr, int wc, int fr, int fq) const {
        const int row0 = u.pm * 256 + wr * 64 + fr, col0 = u.pn * 128 + wc * 32 + 8 * fq;
#pragma unroll
        for (int ai = 0; ai < 2; ++ai)
#pragma unroll
            for (int m = 0; m < 4; ++m) { bf16_t* rowp = O + (size_t)(row0 + ai * 128 + m * 16) * DFF + col0;
                const f32x4 a0 = acc[ai][0][m][0], a1 = acc[ai][0][m][1], b0 = acc[ai][1][m][0], b1 = acc[ai][1][m][1];
                u32x4 w;
                w.x = cvt_pk_bf16(silu_f(a0[0]) * b0[0], silu_f(a0[1]) * b0[1]); w.y = cvt_pk_bf16(silu_f(a0[2]) * b0[2], silu_f(a0[3]) * b0[3]);
                w.z = cvt_pk_bf16(silu_f(a1[0]) * b1[0], silu_f(a1[1]) * b1[1]); w.w = cvt_pk_bf16(silu_f(a1[2]) * b1[2], silu_f(a1[3]) * b1[3]);
                *(u32x4*)rowp = w; }
    }
};
struct EpiResid {
    static constexpr bool PERM = true, AFTER_DRAIN = false;
    bf16_t* xb; const float* modl; int goff; float gscale;
    __device__ __forceinline__ void operator()(const f32x4 (&acc)[2][2][4][2], const Unit& u, int wr, int wc, int fr, int fq) const {
        const int row0 = u.pm * 256 + wr * 64 + fr, col0 = u.pn * 256 + wc * 32 + 8 * fq;
        bf16_t* X = xb + (size_t)row0 * D + col0;
        const float* gp = modl + (size_t)(u.pm < 128 ? (u.pm >> 3) : 16) * 6144 + goff + col0;
        f32x4 gv[2][2];
#pragma unroll
        for (int bj = 0; bj < 2; ++bj)
#pragma unroll
            for (int n = 0; n < 2; ++n) gv[bj][n] = *(const f32x4*)(gp + bj * 128 + 4 * n) * gscale;
#pragma unroll
        for (int ai = 0; ai < 2; ++ai)
#pragma unroll
            for (int m = 0; m < 4; ++m) { bf16_t* rowp = X + (size_t)(ai * 128 + m * 16) * D;
#pragma unroll
                for (int bj = 0; bj < 2; ++bj) { const u32x4 xw = *(const u32x4*)(rowp + bj * 128);
                    const f32x4 v0 = gv[bj][0] * acc[ai][bj][m][0] + (f32x4){bflo(xw.x), bfhi(xw.x), bflo(xw.y), bfhi(xw.y)};
                    const f32x4 v1 = gv[bj][1] * acc[ai][bj][m][1] + (f32x4){bflo(xw.z), bfhi(xw.z), bflo(xw.w), bfhi(xw.w)};
                    u32x4 o; o.x = cvt_pk_bf16(v0[0], v0[1]); o.y = cvt_pk_bf16(v0[2], v0[3]); o.z = cvt_pk_bf16(v1[0], v1[1]); o.w = cvt_pk_bf16(v1[2], v1[3]);
                    *(u32x4*)(rowp + bj * 128) = o; } }
    }
};
struct SplitOrder {
    int G, c, ntk;
    __device__ __forceinline__ bool next(int i, Unit& u) const {
        const int L = i * G + c; if (L >= 256) return false;
        const int tile = L >> 2, ks = L & 3;
        u.pm = 128 + (tile >> 2); u.pn = tile & 3;
        if (ntk == 16) { u.k0 = 4 * ks; u.nt = 4; } else { u.k0 = 11 * ks + (ks & 1); u.nt = 12 - 2 * (ks & 1); }
        return true;
    }
    __device__ __forceinline__ void a_ready(const Unit&) const {}
    __device__ __forceinline__ void done(const Unit&) const {}
};
struct EpiPartial {
    static constexpr bool PERM = false, AFTER_DRAIN = false;
    float* scr; const float* modl; int goff;
    __device__ __forceinline__ void operator()(const f32x4 (&acc)[2][2][4][2], const Unit& u, int wr, int wc, int fr, int fq) const {
        const int row0 = u.pm * 256 + wr * 64 + fr, col0 = u.pn * 256 + wc * 32 + 4 * fq;
        const int ks = (u.nt == 4) ? (u.k0 >> 2) : (u.k0 + 2) / 12;
        float* X = scr + ((size_t)ks * RCTX + (size_t)(row0 - RLAT)) * D;
        const float* gp = modl + (size_t)16 * 6144 + goff + col0;
        f32x4 gv[2][2];
#pragma unroll
        for (int bj = 0; bj < 2; ++bj)
#pragma unroll
            for (int n = 0; n < 2; ++n) gv[bj][n] = *(const f32x4*)(gp + bj * 128 + n * 16);
#pragma unroll
        for (int ai = 0; ai < 2; ++ai)
#pragma unroll
            for (int m = 0; m < 4; ++m) { float* rowp = X + (size_t)(ai * 128 + m * 16) * D + col0;
#pragma unroll
                for (int bj = 0; bj < 2; ++bj)
#pragma unroll
                    for (int n = 0; n < 2; ++n) *(f32x4*)(rowp + bj * 128 + n * 16) = gv[bj][n] * acc[ai][bj][m][n]; }
    }
};

struct TJob { const float* src; bf16_t* dst; int ld, K, ncols; float scale; };
__device__ __forceinline__ TJob tjob(const Params& p, int item) {
    const int l = item / TJ_ALL; int j = item % TJ_ALL;
    bf16_t* WB = (bf16_t*)(p.ws + WS_WB) + (size_t)l * WL_SZ;
    TJob t; t.scale = 1.f; t.ncols = 64;
    if (j < TJ_IN) { const int n0 = (j >> 4) * 64, k0 = (j & 15) * 64; t.ld = DIN; t.K = D;
        const int c0 = n0 < 1024 ? n0 : (n0 < NP ? n0 + 16 : 1024);
        t.ncols = n0 < NP ? 64 : (n0 == NP ? 16 : 0);
        t.src = p.in[8] + (size_t)l * D * DIN + (size_t)k0 * DIN + c0; t.dst = WB + WL_IN + (size_t)n0 * D + k0; if (n0 < 512) t.scale = 0.08838834764831845f; }
    else if (j < TJ_OUT) { j -= TJ_IN; const int n0 = (j >> 4) * 64, k0 = (j & 15) * 64; t.ld = D; t.K = D; t.src = p.in[15] + (size_t)l * D * D + (size_t)k0 * D + n0; t.dst = WB + WL_OUT + (size_t)n0 * D + k0; }
    else if (j < TJ_13) { j -= TJ_OUT; const int n0 = (j >> 4) * 64, k0 = (j & 15) * 64; const int pn = n0 >> 8, bj = (n0 >> 7) & 1, r0 = n0 & 127;
        t.ld = DFF; t.K = D; t.src = (bj ? p.in[17] : p.in[16]) + (size_t)l * D * DFF + (size_t)k0 * DFF + pn * 128 + r0; t.dst = WB + WL_13 + (size_t)n0 * D + k0; }
    else { j -= TJ_13; const int n0 = (j / 44) * 64, k0 = (j % 44) * 64; t.ld = D; t.K = DFF; t.src = p.in[18] + (size_t)l * DFF * D + (size_t)k0 * D + n0; t.dst = WB + WL_2 + (size_t)n0 * DFF + k0; }
    return t;
}
__device__ void phase_prep(const Params& p, LAS unsigned char* lds) {
    const int tid = tid_l(), w = tid >> 6, lane = tid & 63;
    float* MOD = (float*)(p.ws + WS_MOD);
    {
        LAS float* S = (LAS float*)lds;
        LAS float* R = S + 17 * 1024;
        for (int i = tid; i < 17 * 1024; i += 512) { const int r = i >> 10, k = i & 1023; const float v = r < 16 ? p.in[1][r * 1024 + k] : p.in[3][k]; S[i] = v / (1.f + expf(-v)); }
        __syncthreads();
        for (int item = bid_l(); item < 384; item += gridDim.x) {
            const int l = item / 96, n0 = (item % 96) * 64;
            const float* wa = p.in[4] + (size_t)l * 1024 * 6144 + n0 + lane;
            float acc[17];
#pragma unroll
            for (int r = 0; r < 17; ++r) acc[r] = 0.f;
#pragma unroll 4
            for (int k4 = 0; k4 < 32; ++k4) {
                const int k = w * 128 + k4 * 4;
                const float w0 = wa[(size_t)k * 6144], w1 = wa[(size_t)(k + 1) * 6144], w2 = wa[(size_t)(k + 2) * 6144], w3 = wa[(size_t)(k + 3) * 6144];
#pragma unroll
                for (int r = 0; r < 17; ++r) { const f32x4 s = *(const LAS f32x4*)(S + r * 1024 + k); acc[r] += s[0] * w0 + s[1] * w1 + s[2] * w2 + s[3] * w3; }
            }
#pragma unroll
            for (int r = 0; r < 17; ++r) R[(w * 17 + r) * 64 + lane] = acc[r];
            __syncthreads();
            for (int o = tid; o < 17 * 64; o += 512) { const int r = o >> 6, n = o & 63; float s = 0.f;
#pragma unroll
                for (int ww = 0; ww < 8; ++ww) s += R[(ww * 17 + r) * 64 + n];
                MOD[((size_t)l * 17 + r) * 6144 + n0 + n] = s + p.in[5][l * 6144 + n0 + n]; }
            __syncthreads();
        }
    }
    {
        LAS float* T = (LAS float*)lds;
        for (int base = bid_l() * 4; base < DEPTH * TJ_ALL; base += gridDim.x * 4) {
            f32x4 v[4][2];
#pragma unroll
            for (int u = 0; u < 4; ++u) { const TJob jb = tjob(p, base + u);
#pragma unroll
                for (int hh = 0; hh < 2; ++hh) { const int k = (tid >> 4) + 32 * hh, n4 = (tid & 15) * 4; v[u][hh] = n4 < jb.ncols ? *(const f32x4*)(jb.src + (size_t)k * jb.ld + n4) * jb.scale : (f32x4){0.f, 0.f, 0.f, 0.f}; } }
#pragma unroll
            for (int u = 0; u < 4; ++u)
#pragma unroll
                for (int hh = 0; hh < 2; ++hh) { const int k = (tid >> 4) + 32 * hh, n4 = (tid & 15) * 4; LAS float* Tu = T + u * 4160 + k * 65 + n4;
                    Tu[0] = v[u][hh][0]; Tu[1] = v[u][hh][1]; Tu[2] = v[u][hh][2]; Tu[3] = v[u][hh][3]; }
            __syncthreads();
#pragma unroll
            for (int u = 0; u < 4; ++u) { const TJob jb = tjob(p, base + u); const LAS float* Tu = T + u * 4160;
                const int n = tid >> 3, k8 = (tid & 7) * 8; u32x4 o;
                o.x = cvt_pk_bf16(Tu[(k8 + 0) * 65 + n], Tu[(k8 + 1) * 65 + n]); o.y = cvt_pk_bf16(Tu[(k8 + 2) * 65 + n], Tu[(k8 + 3) * 65 + n]);
                o.z = cvt_pk_bf16(Tu[(k8 + 4) * 65 + n], Tu[(k8 + 5) * 65 + n]); o.w = cvt_pk_bf16(Tu[(k8 + 6) * 65 + n], Tu[(k8 + 7) * 65 + n]);
                *(u32x4*)(jb.dst + (size_t)n * jb.K + k8) = o; }
            __syncthreads();
        }
    }
    {
        u32x2* xd = (u32x2*)(p.ws + WS_XB);
        const f32x4* xs = (const f32x4*)p.in[0];
        for (size_t i = (size_t)bid_l() * 512 + tid; i < (size_t)RLAT * D / 4; i += (size_t)gridDim.x * 512) { const f32x4 v = xs[i]; u32x2 o; o.x = cvt_pk_bf16(v[0], v[1]); o.y = cvt_pk_bf16(v[2], v[3]); xd[i] = o; }
        const f32x4* cs = (const f32x4*)p.in[2]; u32x2* cd = xd + (size_t)RLAT * D / 4;
        for (size_t i = (size_t)bid_l() * 512 + tid; i < (size_t)RCTX * D / 4; i += (size_t)gridDim.x * 512) { const f32x4 v = cs[i]; u32x2 o; o.x = cvt_pk_bf16(v[0], v[1]); o.y = cvt_pk_bf16(v[2], v[3]); cd[i] = o; }
    }
}

typedef __bf16 bf16v2 __attribute__((ext_vector_type(2)));
__device__ __forceinline__ float dot2bf(unsigned a, unsigned b, float c) { return __builtin_amdgcn_fdot2_f32_bf16(__builtin_bit_cast(bf16v2, a), __builtin_bit_cast(bf16v2, b), c, false); }
__device__ __forceinline__ void gates_row(const u32x2 (&y)[4], const LAS bf16_t* Wgt, int lane, float* gout, const float* bg) {
    float gv[16];
#pragma unroll
    for (int n = 0; n < 16; ++n) { float f = 0.f;
#pragma unroll
        for (int j = 0; j < 4; ++j) { const u32x2 wv = *(const LAS u32x2*)(Wgt + n * 1024 + j * 256 + lane * 4); f = dot2bf(y[j].x, wv.x, f); f = dot2bf(y[j].y, wv.y, f); }
        gv[n] = f; }
    { const bool hi = lane & 32;
#pragma unroll
        for (int i = 0; i < 8; ++i) { const float send = hi ? gv[i] : gv[i + 8], keep = hi ? gv[i + 8] : gv[i]; gv[i] = keep + __shfl_xor(send, 32); } }
    { const bool hi = lane & 16;
#pragma unroll
        for (int i = 0; i < 4; ++i) { const float send = hi ? gv[i] : gv[i + 4], keep = hi ? gv[i + 4] : gv[i]; gv[i] = keep + __shfl_xor(send, 16); } }
    { const bool hi = lane & 8;
#pragma unroll
        for (int i = 0; i < 2; ++i) { const float send = hi ? gv[i] : gv[i + 2], keep = hi ? gv[i + 2] : gv[i]; gv[i] = keep + __shfl_xor(send, 8); } }
    { const bool hi = lane & 4; const float send = hi ? gv[0] : gv[1], keep = hi ? gv[1] : gv[0]; gv[0] = keep + __shfl_xor(send, 4); }
    gv[0] += __shfl_xor(gv[0], 2); gv[0] += __shfl_xor(gv[0], 1);
    const int n = (lane >> 2) & 15;
    if ((lane & 3) == 0) gout[n] = gv[0] + bg[n];
}
template <int MODE> __device__ void phase_norm(const Params& p, int l, int nrows, bool parts, LAS unsigned char* lds) {
    const int tid = tid_l(), w = tid >> 6, lane = tid & 63;
    const float* nw = MODE == 0 ? p.in[6] + l * D : (MODE == 1 ? p.in[7] + l * D : p.in[19]);
    const float* MOD = (const float*)(p.ws + WS_MOD) + (size_t)l * 17 * 6144;
    bf16_t* ACT = (bf16_t*)(p.ws + WS_ACT); float* GATES = (float*)(p.ws + WS_GATES); bf16_t* XB = (bf16_t*)(p.ws + WS_XB);
    f32x4 nv[4];
#pragma unroll
    for (int j = 0; j < 4; ++j) nv[j] = *(const f32x4*)(nw + j * 256 + lane * 4);
    const int rstride = gridDim.x * 8;
    for (int rowa = bid_l() * 8 + w; rowa < nrows; rowa += 2 * rstride) {
        f32x4 xv[2][4]; float rstd[2];
#pragma unroll
        for (int q = 0; q < 2; ++q) { const int row = rowa + q * rstride; bf16_t* xr = XB + (size_t)row * D + lane * 4;
#pragma unroll
            for (int j = 0; j < 4; ++j) { const u32x2 u = *(const u32x2*)(xr + j * 256); xv[q][j] = (f32x4){bflo(u.x), bfhi(u.x), bflo(u.y), bfhi(u.y)}; }
            if (MODE != 2 && parts && row >= RLAT) {
                const float* sp = (const float*)((const unsigned char*)p.out + OUT_SCR) + (size_t)(row - RLAT) * D + lane * 4;
#pragma unroll
                for (int j = 0; j < 4; ++j) { xv[q][j] += *(const f32x4*)(sp + j * 256) + *(const f32x4*)(sp + (size_t)RCTX * D + j * 256) + *(const f32x4*)(sp + (size_t)2 * RCTX * D + j * 256) + *(const f32x4*)(sp + (size_t)3 * RCTX * D + j * 256);
                    u32x2 o; o.x = cvt_pk_bf16(xv[q][j][0], xv[q][j][1]); o.y = cvt_pk_bf16(xv[q][j][2], xv[q][j][3]); *(u32x2*)(xr + j * 256) = o;
                    xv[q][j] = (f32x4){bflo(o.x), bfhi(o.x), bflo(o.y), bfhi(o.y)}; } } }
#pragma unroll
        for (int q = 0; q < 2; ++q) { float ss = 0.f;
#pragma unroll
            for (int j = 0; j < 4; ++j) ss += xv[q][j][0] * xv[q][j][0] + xv[q][j][1] * xv[q][j][1] + xv[q][j][2] * xv[q][j][2] + xv[q][j][3] * xv[q][j][3];
#pragma unroll
            for (int o = 32; o >= 1; o >>= 1) ss += __shfl_xor(ss, o);
            rstd[q] = rsqrtf(ss * (1.f / 1024.f) + EPS); }
        if (MODE == 2) {
#pragma unroll
            for (int q = 0; q < 2; ++q)
#pragma unroll
                for (int j = 0; j < 4; ++j) *(f32x4*)(p.out + (size_t)(rowa + q * rstride) * D + j * 256 + lane * 4) = xv[q][j] * rstd[q] * nv[j];
            continue;
        }
        u32x2 yp[2][4];
#pragma unroll
        for (int q = 0; q < 2; ++q) { const int row = rowa + q * rstride;
            const float* mr = MOD + (size_t)(row < RLAT ? (row >> 11) : 16) * 6144 + (MODE == 0 ? 0 : 3072);
#pragma unroll
            for (int j = 0; j < 4; ++j) { const f32x4 sh = *(const f32x4*)(mr + j * 256 + lane * 4), scl = *(const f32x4*)(mr + 1024 + j * 256 + lane * 4);
                const f32x4 yv = xv[q][j] * rstd[q] * nv[j] * (scl + 1.f) + sh;
                u32x2 o; o.x = cvt_pk_bf16(yv[0], yv[1]); o.y = cvt_pk_bf16(yv[2], yv[3]); yp[q][j] = o;
                *(u32x2*)(ACT + (size_t)row * D + j * 256 + lane * 4) = o; } }
    }
}

typedef short s16x4 __attribute__((ext_vector_type(4)));
__device__ __forceinline__ unsigned offb(unsigned row, unsigned ch) { return 256u * row + 16u * (ch ^ (((row & 3u) << 2) | ((row >> 2) & 3u))); }
__device__ __forceinline__ bf16x8 rd_row(const LAS unsigned char* img, unsigned row, unsigned ch) { return *(const LAS bf16x8*)(img + offb(row, ch)); }
__device__ __forceinline__ bf16x8 rd_tr(const LAS unsigned char* img, unsigned lane, unsigned c, unsigned ks) {
    const unsigned g = lane >> 4, q = (lane & 15u) >> 2, pp = lane & 3u;
    const unsigned r0 = 32u * ks + 8u * g + q;
    const s16x4 a = __builtin_amdgcn_ds_read_tr16_b64_v4i16((LAS s16x4*)(img + offb(r0, 2u * c + (pp >> 1)) + 8u * (pp & 1u)));
    const s16x4 b = __builtin_amdgcn_ds_read_tr16_b64_v4i16((LAS s16x4*)(img + offb(r0 + 4u, 2u * c + (pp >> 1)) + 8u * (pp & 1u)));
    return __builtin_shufflevector(a, b, 0, 1, 2, 3, 4, 5, 6, 7);
}
__device__ void chain_item(const Params& p, int item, bool last, LAS unsigned char* lds) {
    const int tid = tid_l(), w = __builtin_amdgcn_readfirstlane(tid >> 6), lane = tid & 63, fr = lane & 15, fq = lane >> 4;
    const int vh = item & 1, dir = (item >> 1) & 1, h = (item >> 2) & 3, b = item >> 4;
    LAS unsigned char* Qs = lds;
    LAS unsigned char* Kw = lds + 32768;
    LAS unsigned char* Vs = lds + 65536;
    LAS unsigned char* Ct = lds + 98304;
    LAS float* s_a = (LAS float*)(lds + 114688);
    LAS float* s_cm = s_a + 18 * 128;
    LAS float* s_b = s_cm + 18 * 128;
    LAS float* s_nv = s_b + 18 * 128;
    const bf16_t* PB = (const bf16_t*)(p.ws + WS_PBUF); const float* GATES = (const float*)(p.ws + WS_GATES);
    bf16_t* ACT = (bf16_t*)(p.ws + WS_ACT); bf16_t* HB = (bf16_t*)p.out;
#define CHUNK_BASE(s) (dir == 0 ? ((s) < 2 ? RLAT + b * CTXL + 128 * (s) : b * SEQ + 128 * ((s) - 2)) : ((s) < 2 ? RLAT + b * CTXL + 128 * (1 - (s)) : b * SEQ + 128 * (17 - (s))))
#define LOAD_CHUNK(s) do { const int _base = CHUNK_BASE(s); \
        _Pragma("unroll") for (int e = 0; e < 4; ++e) { const int _row = e * 32 + (tid >> 4); const int _tok = _base + (dir ? 127 - _row : _row); \
            const bf16_t* _pr = PB + (size_t)_tok * NP + 128 * h + (tid & 15) * 8; qreg[e] = *(const u32x4*)(_pr + PQ); kreg[e] = *(const u32x4*)(_pr + PK); vreg[e] = *(const u32x4*)(_pr + PV); } } while (0)
    u32x4 qreg[4], kreg[4], vreg[4];
    LOAD_CHUNK(0);
    for (int j = w; j < 18; j += 8) {
        const int cb = CHUNK_BASE(j);
        const int t0 = cb + (dir ? 127 - 2 * lane : 2 * lane), t1 = cb + (dir ? 126 - 2 * lane : 2 * lane + 1);
        const float* g0 = GATES + (size_t)t0 * 16 + dir * 8 + h; const float* g1 = GATES + (size_t)t1 * 16 + dir * 8 + h;
        const float i0 = g0[0], f0 = g0[4], i1 = g1[0], f1 = g1[4];
        const float l0 = fminf(f0, 0.f) - log1pf(expf(-fabsf(f0))), l1 = fminf(f1, 0.f) - log1pf(expf(-fabsf(f1)));
        float incl = l0 + l1;
#pragma unroll
        for (int off = 1; off < 64; off <<= 1) { const float tv = __shfl_up(incl, off); if (lane >= off) incl += tv; }
        const float b1 = incl, b0 = incl - l1;
        const float a0 = i0 - b0, a1 = i1 - b1;
        float mx = fmaxf(a0, a1);
#pragma unroll
        for (int off = 1; off < 64; off <<= 1) { const float tv = __shfl_up(mx, off); if (lane >= off) mx = fmaxf(mx, tv); }
        float ex = __shfl_up(mx, 1); if (lane == 0) ex = -INFINITY;
        s_a[j * 128 + 2 * lane] = a0; s_a[j * 128 + 2 * lane + 1] = a1;
        s_cm[j * 128 + 2 * lane] = fmaxf(ex, a0); s_cm[j * 128 + 2 * lane + 1] = mx;
        s_b[j * 128 + 2 * lane] = b0; s_b[j * 128 + 2 * lane + 1] = b1;
    }
    for (int i = tid; i < 16384 / 4; i += 512) ((LAS unsigned*)Ct)[i] = 0u;
    if (tid < 128) s_nv[tid] = 0.f;
    f32x4 cacc[4], nacc = (f32x4){0.f, 0.f, 0.f, 0.f};
#pragma unroll
    for (int x = 0; x < 4; ++x) cacc[x] = (f32x4){0.f, 0.f, 0.f, 0.f};
    float m_st = 0.f;
    bf16x8 ones;
#pragma unroll
    for (int x = 0; x < 8; ++x) ones[x] = (short)0x3F80;
    __syncthreads();
    const int t = 16 * w + fr;
    const int jt_s = w & 3, it0 = (w >> 2) * 4;
    for (int s = 0; s < 18; ++s) {
        const int base = CHUNK_BASE(s);
        const float c127 = fmaxf(m_st, s_cm[s * 128 + 127]), b127 = s_b[s * 128 + 127];
        const float decay = expf(m_st - c127);
#pragma unroll
        for (int e = 0; e < 4; ++e) { const int row = e * 32 + (tid >> 4), ch = tid & 15; const float wv = expf(s_a[s * 128 + row] - c127); u32x4 o;
#pragma unroll
            for (int x = 0; x < 4; ++x) { const unsigned u = kreg[e][x]; o[x] = cvt_pk_bf16(bflo(u) * wv, bfhi(u) * wv); }
            const unsigned ob = offb(row, ch);
            *(LAS u32x4*)(Qs + ob) = qreg[e]; *(LAS u32x4*)(Kw + ob) = o; *(LAS u32x4*)(Vs + ob) = vreg[e]; }
        if (s + 1 < 18) LOAD_CHUNK(s + 1);
        __syncthreads();
        bf16x8 qa[4];
#pragma unroll
        for (int kk = 0; kk < 4; ++kk) qa[kk] = rd_row(Qs, t, 4 * kk + fq);
        float qn = 0.f;
#pragma unroll
        for (int kk = 0; kk < 4; ++kk) { const f32x4 n0 = *(const LAS f32x4*)(s_nv + 32 * kk + 8 * fq), n1 = *(const LAS f32x4*)(s_nv + 32 * kk + 8 * fq + 4);
            qn += bf2f(qa[kk][0]) * n0[0] + bf2f(qa[kk][1]) * n0[1] + bf2f(qa[kk][2]) * n0[2] + bf2f(qa[kk][3]) * n0[3]
                + bf2f(qa[kk][4]) * n1[0] + bf2f(qa[kk][5]) * n1[1] + bf2f(qa[kk][6]) * n1[2] + bf2f(qa[kk][7]) * n1[3]; }
        qn += __shfl_xor(qn, 16); qn += __shfl_xor(qn, 32);
        float rs = 0.f;
#pragma unroll
        for (int n = 0; n < 8; ++n) { if (n > (w | 1)) continue;
            f32x4 sa = (f32x4){0.f, 0.f, 0.f, 0.f};
#pragma unroll
            for (int kk = 0; kk < 4; ++kk) sa = mfma16(rd_row(Kw, 16 * n + fr, 4 * kk + fq), qa[kk], sa);
#pragma unroll
            for (int r = 0; r < 4; ++r) { const int s_ = 16 * n + 4 * fq + r; sa[r] = (s_ <= t) ? sa[r] : 0.f; rs += sa[r]; }
            u32x2 pk; pk.x = cvt_pk_bf16(sa[0], sa[1]); pk.y = cvt_pk_bf16(sa[2], sa[3]);
            *(LAS u32x2*)(Qs + offb(t, 2 * n + (fq >> 1)) + 8 * (fq & 1)) = pk; }
        rs += __shfl_xor(rs, 16); rs += __shfl_xor(rs, 32);
        f32x4 u1[4], u2[4];
#pragma unroll
        for (int jt = 0; jt < 4; ++jt) { u2[jt] = (f32x4){0.f, 0.f, 0.f, 0.f};
#pragma unroll
            for (int kk = 0; kk < 4; ++kk) u2[jt] = mfma16(rd_row(Ct, 16 * jt + fr, 4 * kk + fq), qa[kk], u2[jt]); }
        { bf16x8 pb[4];
#pragma unroll
            for (int kk = 0; kk < 4; ++kk) pb[kk] = rd_row(Qs, t, 4 * kk + fq);
#pragma unroll
            for (int jt = 0; jt < 4; ++jt) u1[jt] = (f32x4){0.f, 0.f, 0.f, 0.f};
#pragma unroll
            for (int kk = 0; kk < 4; ++kk) { if (kk > (w >> 1)) continue;
#pragma unroll
                for (int jt = 0; jt < 4; ++jt) u1[jt] = mfma16(rd_tr(Vs, lane, 4 * vh + jt, kk), pb[kk], u1[jt]); } }
        if (!(last && s < 2)) {
            const float ct = fmaxf(m_st, s_cm[s * 128 + t]);
            const float gt = expf(c127 - ct), it = expf(m_st - ct), em = expf(-(s_b[s * 128 + t] + ct));
            const float den = gt * rs + it * qn; const float inv = 1.f / fmaxf(fabsf(den), em);
            const int tok = base + (dir ? 127 - t : t);
            bf16_t* dst = (dir == 0 ? ACT + (size_t)tok * D : HB + (size_t)tok * 512) + 128 * h + 64 * vh + 4 * fq;
#pragma unroll
            for (int jt = 0; jt < 4; ++jt) { u32x2 o; o.x = cvt_pk_bf16((gt * u1[jt][0] + it * u2[jt][0]) * inv, (gt * u1[jt][1] + it * u2[jt][1]) * inv);
                o.y = cvt_pk_bf16((gt * u1[jt][2] + it * u2[jt][2]) * inv, (gt * u1[jt][3] + it * u2[jt][3]) * inv);
                *(u32x2*)(dst + 16 * jt) = o; }
        }
#pragma unroll
        for (int x = 0; x < 4; ++x) cacc[x] *= decay;
        nacc *= decay;
#pragma unroll
        for (int kk = 0; kk < 4; ++kk) { const bf16x8 vb = rd_tr(Vs, lane, 4 * vh + jt_s, kk);
#pragma unroll
            for (int x = 0; x < 4; ++x) cacc[x] = mfma16(rd_tr(Kw, lane, it0 + x, kk), vb, cacc[x]);
            nacc = mfma16(rd_tr(Kw, lane, w, kk), ones, nacc); }
        m_st = b127 + c127;
        __syncthreads();
#pragma unroll
        for (int x = 0; x < 4; ++x) { u32x2 o; o.x = cvt_pk_bf16(cacc[x][0], cacc[x][1]); o.y = cvt_pk_bf16(cacc[x][2], cacc[x][3]);
            *(LAS u32x2*)(Ct + offb(16 * jt_s + fr, 2 * (it0 + x) + (fq >> 1)) + 8 * (fq & 1)) = o; }
        if (fr == 0) *(LAS f32x4*)(s_nv + 16 * w + 4 * fq) = nacc;
    }
    __syncthreads();
#undef LOAD_CHUNK
#undef CHUNK_BASE
}

__device__ void gmlp_item(const Params& p, int l, int ch, LAS unsigned char* lds) {
    const int tid = tid_l(), w = tid >> 6, lane = tid & 63, fr = lane & 15, fq = lane >> 4;
    const bf16_t* PB = (const bf16_t*)(p.ws + WS_PBUF); bf16_t* ACT = (bf16_t*)(p.ws + WS_ACT);
    const int row0 = ch * 128;
    { const int c8 = (tid & 31) * 8; const float* gn = p.in[12] + l * 256 + c8;
        const f32x4 g0 = *(const f32x4*)gn, g1 = *(const f32x4*)(gn + 4);
        u32x4 vv[8];
#pragma unroll
        for (int ps = 0; ps < 8; ++ps) vv[ps] = *(const u32x4*)(PB + (size_t)(row0 + ps * 16 + (tid >> 5)) * NP + PGV + c8);
#pragma unroll
        for (int ps = 0; ps < 8; ++ps) { const int s = ps * 16 + (tid >> 5);
            const u32x4 v = vv[ps];
            float f[8]; f[0] = bflo(v.x); f[1] = bfhi(v.x); f[2] = bflo(v.y); f[3] = bfhi(v.y); f[4] = bflo(v.z); f[5] = bfhi(v.z); f[6] = bflo(v.w); f[7] = bfhi(v.w);
            float ss = 0.f;
#pragma unroll
            for (int x = 0; x < 8; ++x) ss += f[x] * f[x];
#pragma unroll
            for (int o = 16; o >= 1; o >>= 1) ss += __shfl_xor(ss, o);
            const float rstd = rsqrtf(ss * (1.f / 256.f) + EPS);
            u32x4 o; o.x = cvt_pk_bf16(f[0] * rstd * g0[0], f[1] * rstd * g0[1]); o.y = cvt_pk_bf16(f[2] * rstd * g0[2], f[3] * rstd * g0[3]);
            o.z = cvt_pk_bf16(f[4] * rstd * g1[0], f[5] * rstd * g1[1]); o.w = cvt_pk_bf16(f[6] * rstd * g1[2], f[7] * rstd * g1[3]);
            *(LAS u32x4*)(lds + 32768 * ((tid & 31) >> 4) + offb(s, tid & 15)) = o; } }
    __syncthreads();
    const int t = 16 * w + fr;
    const size_t grow = (size_t)(row0 + t);
#pragma unroll 1
    for (int g = 0; g < 4; ++g) {
        const float* wsr = p.in[13] + (((size_t)l * 4 + g) * 128 + t) * 128;
        bf16x8 wb[4];
#pragma unroll
        for (int kk = 0; kk < 4; ++kk) { const f32x4 a = *(const f32x4*)(wsr + 32 * kk + 8 * fq), c = *(const f32x4*)(wsr + 32 * kk + 8 * fq + 4);
            u32x4 o; o.x = cvt_pk_bf16(a[0], a[1]); o.y = cvt_pk_bf16(a[2], a[3]); o.z = cvt_pk_bf16(c[0], c[1]); o.w = cvt_pk_bf16(c[2], c[3]);
            wb[kk] = __builtin_bit_cast(bf16x8, o); }
        const float bs = p.in[14][((size_t)l * 4 + g) * 128 + t];
        const LAS unsigned char* img = lds + 32768 * (g >> 1);
#pragma unroll
        for (int cc = 0; cc < 4; ++cc) { const int ct = 4 * g + cc; f32x4 acc = (f32x4){0.f, 0.f, 0.f, 0.f};
#pragma unroll
            for (int kk = 0; kk < 4; ++kk) acc = mfma16(rd_tr(img, lane, ct & 7, kk), wb[kk], acc);
            const int c = 16 * ct + 4 * fq;
            const u32x2 uu = *(const u32x2*)(PB + grow * NP + PGU + c);
            u32x2 o; o.x = cvt_pk_bf16(bflo(uu.x) * (acc[0] + bs), bfhi(uu.x) * (acc[1] + bs)); o.y = cvt_pk_bf16(bflo(uu.y) * (acc[2] + bs), bfhi(uu.y) * (acc[3] + bs));
            *(u32x2*)(ACT + grow * D + 768 + c) = o; }
    }
    __syncthreads();
}

__device__ void conv_all(const Params& p, int l, int nrows) {
    const bf16_t* PB = (const bf16_t*)(p.ws + WS_PBUF); bf16_t* ACT = (bf16_t*)(p.ws + WS_ACT);
    const float* cw = p.in[11] + (size_t)l * 3 * 256;
    for (int idx = bid_l() * 512 + tid_l(); idx < nrows * 32; idx += gridDim.x * 512) {
        const int row = idx >> 5, c8 = (idx & 31) * 8;
        bool hp, hn;
        if (row < RLAT) { const int pos = row & 63; hp = pos > 0; hn = pos < 63; } else { const int pos = (row - RLAT) & 255; hp = pos > 0; hn = pos < 255; }
        const bf16_t* pr = PB + (size_t)row * NP + c8;
        const u32x4 gb = *(const u32x4*)(pr + PCB);
        const u32x4 c1 = *(const u32x4*)(pr + PCC), h1 = *(const u32x4*)(pr + PCH);
        u32x4 c0 = (u32x4){0u, 0u, 0u, 0u}, h0 = c0, c2 = c0, h2 = c0;
        if (hp) { c0 = *(const u32x4*)(pr - NP + PCC); h0 = *(const u32x4*)(pr - NP + PCH); }
        if (hn) { c2 = *(const u32x4*)(pr + NP + PCC); h2 = *(const u32x4*)(pr + NP + PCH); }
        u32x4 o;
#pragma unroll
        for (int x = 0; x < 4; ++x) {
            const int c = c8 + 2 * x;
            const float ylo = cw[c] * (bflo(c0[x]) * bflo(h0[x])) + cw[256 + c] * (bflo(c1[x]) * bflo(h1[x])) + cw[512 + c] * (bflo(c2[x]) * bflo(h2[x]));
            const float yhi = cw[c + 1] * (bfhi(c0[x]) * bfhi(h0[x])) + cw[256 + c + 1] * (bfhi(c1[x]) * bfhi(h1[x])) + cw[512 + c + 1] * (bfhi(c2[x]) * bfhi(h2[x]));
            o[x] = cvt_pk_bf16(bflo(gb[x]) * ylo, bfhi(gb[x]) * yhi);
        }
        *(u32x4*)(ACT + (size_t)row * D + 512 + c8) = o;
    }
}

__device__ void combine_all(const Params& p, int l, int nrows) {
    const bf16_t* PB = (const bf16_t*)(p.ws + WS_PBUF); bf16_t* ACT = (bf16_t*)(p.ws + WS_ACT); const bf16_t* HB = (const bf16_t*)p.out;
    const float* mn = p.in[10] + (size_t)l * 512;
    for (int idx = bid_l() * 512 + tid_l(); idx < nrows * 64; idx += gridDim.x * 512) {
        const int row = idx >> 6, c8 = (idx & 63) * 8;
        const u32x4 a = *(const u32x4*)(ACT + (size_t)row * D + c8), bb = *(const u32x4*)(HB + (size_t)row * 512 + c8), og = *(const u32x4*)(PB + (size_t)row * NP + PO + c8);
        float f[8]; float ss = 0.f;
#pragma unroll
        for (int x = 0; x < 4; ++x) { f[2 * x] = bflo(a[x]) + bflo(bb[x]); f[2 * x + 1] = bfhi(a[x]) + bfhi(bb[x]); ss += f[2 * x] * f[2 * x] + f[2 * x + 1] * f[2 * x + 1]; }
#pragma unroll
        for (int o = 8; o >= 1; o >>= 1) ss += __shfl_xor(ss, o);
        const float rstd = rsqrtf(ss * (1.f / 128.f) + EPS);
        u32x4 o;
#pragma unroll
        for (int x = 0; x < 4; ++x) {
            const float o0 = 1.f / (1.f + __expf(-bflo(og[x]))), o1 = 1.f / (1.f + __expf(-bfhi(og[x])));
            o[x] = cvt_pk_bf16(o0 * f[2 * x] * rstd * mn[c8 + 2 * x], o1 * f[2 * x + 1] * rstd * mn[c8 + 2 * x + 1]);
        }
        *(u32x4*)(ACT + (size_t)row * D + c8) = o;
    }
}

#include <cstdio>
#include <cstdint>
#include <cstdlib>
#include <vector>

#define XB_TMO      128
#define XB_XCNT(j)  (256  + 64 * (j))
#define XB_XSUB(j)  (1280 + 64 * (j))
#define XB_XGEN(j)  (2304 + 64 * (j))
#define XB_TOP      3328
#define XB_TOPGEN   3392
#define XCD_BAR_WORDS 3456
#define XB_SPIN_CAP (1u << 18)

__device__ __forceinline__ unsigned xb_ld(unsigned* p)              { return __hip_atomic_load(p, __ATOMIC_RELAXED, __HIP_MEMORY_SCOPE_AGENT); }
__device__ __forceinline__ unsigned xb_add(unsigned* p, unsigned v) { return __hip_atomic_fetch_add(p, v, __ATOMIC_RELAXED, __HIP_MEMORY_SCOPE_AGENT); }
__device__ __forceinline__ unsigned xb_xcc_id() { return (unsigned)__builtin_amdgcn_s_getreg((3 << 11) | 20) & 0xFu; }
#define XB_SPIN(cond, bar) do { unsigned _sp = 0; while (cond) { __builtin_amdgcn_s_sleep(1); \
    if ((++_sp & 255u) == 0u) { if (xb_ld(&(bar)[XB_TMO])) break; if (_sp > XB_SPIN_CAP) { atomicAdd(&(bar)[XB_TMO], 1u); break; } } } } while (0)

struct XcdBarrier {
    unsigned* bar; unsigned x;
    volatile LAS unsigned* st;
};

__device__ __forceinline__ XcdBarrier xcd_barrier_post(unsigned* bar, volatile LAS unsigned* st) {
    XcdBarrier b; b.bar = bar; b.x = xb_xcc_id(); b.st = st;
    if (threadIdx.x == 0) (void)xb_add(&bar[XB_XCNT(b.x)], 1u);
    return b;
}
__device__ __forceinline__ void xcd_barrier_complete(unsigned* bar, unsigned x, unsigned& nloc, unsigned& nx) {
    const unsigned G = gridDim.x * gridDim.y * gridDim.z;
    unsigned sum, cnt, mine, sp = 0u;
    for (;;) {
        sum = 0u; cnt = 0u; mine = 0u;
#pragma unroll
        for (unsigned j = 0; j < 16; ++j) { const unsigned c = xb_ld(&bar[XB_XCNT(j)]); sum += c; cnt += (c > 0u) ? 1u : 0u; mine = (j == x) ? c : mine; }
        if (sum == G) break;
        __builtin_amdgcn_s_sleep(1);
        if ((++sp & 255u) == 0u) { if (xb_ld(&bar[XB_TMO])) break; if (sp > XB_SPIN_CAP) { atomicAdd(&bar[XB_TMO], 1u); break; } }
    }
    nloc = mine > 0u ? mine : 1u; nx = cnt > 0u ? cnt : 1u;
}

__device__ __forceinline__ void xcd_barrier(const XcdBarrier& b) {
    asm volatile("s_waitcnt vmcnt(0)" ::: "memory");
    __syncthreads();
    if (threadIdx.x == 0) {
        unsigned* bar = b.bar;
        __builtin_amdgcn_s_waitcnt(0);
        unsigned nloc = b.st[0], nx = b.st[1];
        if (nloc == 0u) { xcd_barrier_complete(bar, b.x, nloc, nx); b.st[0] = nloc; b.st[1] = nx; }
        const unsigned old = xb_add(&bar[XB_XSUB(b.x)], 1u);
        const unsigned gen = old / nloc;
        if (old + 1u == (gen + 1u) * nloc) {
            __builtin_amdgcn_fence(__ATOMIC_RELEASE, "agent");
            asm volatile("s_waitcnt vmcnt(0)" ::: "memory");
            const unsigned og = xb_add(&bar[XB_TOP], 1u);
            const unsigned tg = og / nx;
            if (og + 1u == (tg + 1u) * nx) xb_add(&bar[XB_TOPGEN], 1u);
            else XB_SPIN(xb_ld(&bar[XB_TOPGEN]) == tg, bar);
            __builtin_amdgcn_fence(__ATOMIC_ACQUIRE, "agent");
            xb_add(&bar[XB_XGEN(b.x)], 1u);
            asm volatile("s_waitcnt vmcnt(0)" ::: "memory");
        } else {
            XB_SPIN(xb_ld(&bar[XB_XGEN(b.x)]) == gen, bar);
            __builtin_amdgcn_fence(__ATOMIC_ACQUIRE, "agent");
            asm volatile("s_waitcnt vmcnt(0)" ::: "memory");
        }
    }
    __syncthreads();
}


__device__ __forceinline__ void run_phase(const Params& p, int ph, LAS unsigned char* lds, bool prep = false) {
    if (ph == 0) { phase_prep(p, lds); return; }
    if (ph == NPHASE - 1) { phase_norm<2>(p, 0, RLAT, false, lds); return; }
    const int l = (ph - 1) >> 3, sub = (ph - 1) & 7; const bool last = (l == DEPTH - 1);
    const int nrows = last ? RLAT : ROWS;
    bf16_t* ACT = (bf16_t*)(p.ws + WS_ACT); bf16_t* PBUF = (bf16_t*)(p.ws + WS_PBUF);
    const bf16_t* WB = (const bf16_t*)(p.ws + WS_WB) + (size_t)l * WL_SZ;
    pg8::StaticOrder S;
    if (sub == 0) { phase_norm<0>(p, l, ROWS, l > 0, lds); }
    else if (sub == 1) { pg8::Gemm g; g.A = ACT; g.Bt = WB + WL_IN; g.M = ROWS; g.N = NPB; g.K = D; S.init(g.M, g.N, (int)gridDim.x, (int)bid_l()); S.ntk = g.K / 64;
        EpiP E; E.O = PBUF; E.ldc = NP; E.gates = (float*)(p.ws + WS_GATES); E.bg = p.in[9] + l * 16; pg8::gemm_phase<EpiP, pg8::StaticOrder, false>(lds, g, S, E, nullptr); }
    else if (sub == 2) {
        for (int rep = 0; rep < ((PROBE >> 9) & 1) + 1; ++rep)
        for (int item = bid_l(); item < 256; item += gridDim.x) chain_item(p, item, last, lds);
        for (int rep = 0; rep < ((PROBE >> 10) & 1) + 1; ++rep) {
        for (int ch = bid_l(); ch < nrows / 128; ch += gridDim.x) gmlp_item(p, l, ch, lds);
        conv_all(p, l, nrows); }
    }
    else if (sub == 3) { combine_all(p, l, nrows); }
    else if (sub == 4 || sub == 7) { pg8::Gemm g; g.M = RLAT; g.N = D;
        if (sub == 4) { g.A = ACT; g.Bt = WB + WL_OUT; g.K = D; } else { g.A = PBUF; g.Bt = WB + WL_2; g.K = DFF; }
        S.init(g.M, g.N, (int)gridDim.x, (int)bid_l()); S.ntk = g.K / 64;
        EpiResid E; E.xb = (bf16_t*)(p.ws + WS_XB); E.modl = (const float*)(p.ws + WS_MOD) + (size_t)l * 17 * 6144; E.goff = sub == 4 ? 2048 : 5120; E.gscale = prep ? 0.f : 1.f;
        pg8::gemm_phase<EpiResid, pg8::StaticOrder, false>(lds, g, S, E, nullptr);
        if (!last && !prep) {
            SplitOrder S2; S2.G = (int)gridDim.x; S2.c = (int)bid_l(); S2.ntk = g.K / 64;
            EpiPartial E2; E2.scr = (float*)((unsigned char*)p.out + OUT_SCR); E2.modl = E.modl; E2.goff = E.goff;
            pg8::gemm_phase<EpiPartial, SplitOrder, false>(lds, g, S2, E2, nullptr); } }
    else if (sub == 5) { phase_norm<1>(p, l, nrows, !last, lds); }
    else { pg8::Gemm g; g.A = ACT; g.Bt = WB + WL_13; g.M = nrows; g.N = 2 * DFF; g.K = D; S.init(g.M, g.N, (int)gridDim.x, (int)bid_l()); S.ntk = g.K / 64;
        EpiSwiglu E; E.O = PBUF; pg8::gemm_phase<EpiSwiglu, pg8::StaticOrder, false>(lds, g, S, E, nullptr); }
}

__global__ void __launch_bounds__(512, 2) fwd_kernel(Params p, int ph_lo, int ph_hi) {
    extern __shared__ __attribute__((aligned(16))) unsigned char shm[];
    LAS unsigned char* lds = (LAS unsigned char*)shm;
    cg::grid_group grid = cg::this_grid();
    volatile LAS unsigned* st = (volatile LAS unsigned*)(lds + LDS_BYTES - 16);
    if (threadIdx.x == 0) { st[0] = 0u; st[1] = 0u; }
    __syncthreads();
    const XcdBarrier xb = xcd_barrier_post((unsigned*)(p.ws + WS_BAR), st);
    for (int ph = ph_lo; ph < ph_hi; ++ph) {
        run_phase(p, ph, lds);
        if (PROBE) { const int sub = (ph - 1) & 7; const bool rep = (ph == 0) ? ((PROBE >> 8) & 1) : (ph < NPHASE - 1 && ((PROBE >> sub) & 1));
            if (rep) { if (ph == 0) grid.sync(); else xcd_barrier(xb); run_phase(p, ph, lds, true); } }
        if (ph + 1 < ph_hi) { if (ph == ph_lo) grid.sync(); else xcd_barrier(xb); }
    }
}

extern "C" void kernel_launch(void* const* d_in, const int* in_sizes, int n_in, void* d_out, int out_size, void* d_ws, size_t ws_size, hipStream_t stream) {
    static int grid = 0;
    if (grid == 0) {
        if (n_in != 20 || out_size != RLAT * D || ws_size < WS_END) { fprintf(stderr, "kernel_launch: unexpected shapes (n_in %d, out %d, ws %zu, need %zu)\n", n_in, out_size, ws_size, (size_t)WS_END); grid = -1; return; }
        int dev = 0, cus = 0, per_cu = 0;
        (void)hipGetDevice(&dev); (void)hipDeviceGetAttribute(&cus, hipDeviceAttributeMultiprocessorCount, dev);
        if (hipFuncSetAttribute((const void*)fwd_kernel, hipFuncAttributeMaxDynamicSharedMemorySize, LDS_BYTES) != hipSuccess) { fprintf(stderr, "kernel_launch: hipFuncSetAttribute failed\n"); grid = -1; return; }
        if (hipOccupancyMaxActiveBlocksPerMultiprocessor(&per_cu, (const void*)fwd_kernel, 512, LDS_BYTES) != hipSuccess || per_cu < 1) { fprintf(stderr, "kernel_launch: occupancy query failed (%d)\n", per_cu); (void)hipGetLastError(); per_cu = 1; }
        grid = cus * per_cu;
    }
    if (grid < 0) return;
    if (hipMemsetAsync((char*)d_ws + WS_BAR, 0, 16384, stream) != hipSuccess) { fprintf(stderr, "kernel_launch: memset of barrier words failed\n"); return; }
    Params p{};
    for (int i = 0; i < 20; ++i) p.in[i] = (const float*)d_in[i];
    p.out = (float*)d_out; p.ws = (unsigned char*)d_ws;
    int lo = 0, hi = NPHASE;
    void* args[] = {&p, &lo, &hi};
    hipError_t e = hipLaunchCooperativeKernel((const void*)fwd_kernel, dim3(grid), dim3(512), args, LDS_BYTES, stream);
    if (e != hipSuccess) fprintf(stderr, "kernel_launch: cooperative launch failed: %s (grid %d)\n", hipGetErrorString(e), grid);
}
```
